# Optimizing an MI355X kernel written in HIP

```python
import jax
import jax.numpy as jnp
from jax import lax
import numpy as np

D_MODEL = 1024
BATCH = 8
SEQ = 2048
DEPTH = 4

GRID_W = 64
CTX_LEN = 256
NORM_EPS = 1e-6
N_MOD = 6

POOL_WINDOWS = (2, 4, 8, 16)
POOL_GROUP = 64
POOL_WIDTH = POOL_GROUP * len(POOL_WINDOWS)

N_HEADS = 8
N_KV_HEADS = 2
HEAD_DIM = 64
Q_PER_KV = N_HEADS // N_KV_HEADS
ATTN_WIDTH = N_HEADS * HEAD_DIM
KV_WIDTH = N_KV_HEADS * HEAD_DIM
Q_BLOCK = 128
ROPE_THETA = 10000.0

HG_HEADS = 4
HG_DK = 64
HG_DV = 64
HG_WIDTH = HG_HEADS * HG_DK
HG_CHUNK = 16

D_FF = ((8 * D_MODEL + 3 * 256 - 1) // (3 * 256)) * 256

IN_SIZES = (POOL_WIDTH,
            ATTN_WIDTH, KV_WIDTH, KV_WIDTH,
            HG_WIDTH, HG_WIDTH,
            HG_WIDTH, HG_WIDTH,
            HG_WIDTH,
            D_MODEL, D_MODEL, D_MODEL)
IN_WIDTH = sum(IN_SIZES)
IN_SPLITS = tuple(int(s) for s in np.cumsum(IN_SIZES)[:-1])

kernel_name = "hybrid_pool_gqa_hgrn2_dit_trunk"


def rmsnorm(x, w):
    xf = x.astype(jnp.float32)
    y = xf * lax.rsqrt(jnp.mean(xf * xf, axis=-1, keepdims=True) + NORM_EPS)
    return (y * w.astype(jnp.float32)).astype(x.dtype)


def _rope_axis(x, pos):
    n = x.shape[-1]
    half = n // 2
    freqs = ROPE_THETA ** (-jnp.arange(half, dtype=jnp.float32) * (2.0 / n))
    ang = pos.astype(jnp.float32)[:, None] * freqs[None, :]
    cos = jnp.cos(ang)[None, :, None, :]
    sin = jnp.sin(ang)[None, :, None, :]
    xf = x.astype(jnp.float32)
    x1, x2 = xf[..., :half], xf[..., half:]
    return jnp.concatenate([x1 * cos - x2 * sin, x2 * cos + x1 * sin], axis=-1).astype(x.dtype)


def rope_2d(x, row, col):
    h = x.shape[-1] // 2
    return jnp.concatenate([_rope_axis(x[..., :h], row), _rope_axis(x[..., h:], col)], axis=-1)


def pool_mix(u, w_pool, s_pool):
    B, L, _ = u.shape
    uf = u.astype(jnp.float32)
    cs = jnp.concatenate([jnp.zeros((B, 1, POOL_WIDTH), jnp.float32), jnp.cumsum(uf, axis=1)], axis=1)
    t = jnp.arange(L)
    outs = []
    for gi, w in enumerate(POOL_WINDOWS):
        lo = jnp.clip(t - w // 2, 0, L)
        hi = jnp.clip(t + w - w // 2, 0, L)
        csg = cs[..., gi * POOL_GROUP:(gi + 1) * POOL_GROUP]
        cnt = (hi - lo).astype(jnp.float32)[None, :, None]
        mean = (csg[:, hi] - csg[:, lo]) / cnt
        outs.append(mean - uf[..., gi * POOL_GROUP:(gi + 1) * POOL_GROUP])
    y = jnp.stack(outs, axis=2).astype(u.dtype)
    y = jnp.einsum('blgc,gcd->blgd', y, w_pool).reshape(B, L, POOL_WIDTH)
    return y * s_pool


def _attend(q, k, v):
    s = jnp.einsum('bqhgd,bshd->bhgqs', q, k).astype(jnp.float32) * (HEAD_DIM ** -0.5)
    p = jax.nn.softmax(s, axis=-1).astype(v.dtype)
    return jnp.einsum('bhgqs,bshd->bqhgd', p, v)


def latent_attention(q, k, v, k_ctx, v_ctx):
    B, L = q.shape[:2]
    k_all = jnp.concatenate([k, k_ctx], axis=1)
    v_all = jnp.concatenate([v, v_ctx], axis=1)
    nb = L // Q_BLOCK
    qb = jnp.moveaxis(q.reshape(B, nb, Q_BLOCK, N_KV_HEADS, Q_PER_KV, HEAD_DIM), 1, 0)
    ob = lax.map(lambda blk: _attend(blk, k_all, v_all), qb)
    return jnp.moveaxis(ob, 0, 1).reshape(B, L, ATTN_WIDTH)


def _hgrn_gates(z, lb):
    z = z.astype(jnp.float32)
    log_f = jnp.logaddexp(jnp.log(lb), jnp.log1p(-lb) + jax.nn.log_sigmoid(z))
    one_minus_f = (1.0 - lb) * jax.nn.sigmoid(-z)
    return log_f, one_minus_f


def hgrn_scan(q, k, v, log_f, s0):
    B, L, H, K = q.shape
    V = v.shape[-1]
    C = HG_CHUNK
    N = L // C
    q = q.reshape(B, N, C, H, K)
    k = k.reshape(B, N, C, H, K)
    v = v.reshape(B, N, C, H, V)
    G = jnp.cumsum(log_f.reshape(B, N, C, H, K), axis=2)
    G_last = G[:, :, -1]
    mask = jnp.tril(jnp.ones((C, C), dtype=bool))[None, None, :, :, None, None]
    diff = G[:, :, :, None] - G[:, :, None, :]
    decay = jnp.exp(jnp.where(mask, diff, -jnp.inf))
    A = jnp.einsum('bnthk,bnshk,bntshk->bnhts', q, k, decay)
    o_intra = jnp.einsum('bnhts,bnshv->bnthv', A, v)
    k_dec = k * jnp.exp(G_last[:, :, None] - G)
    kv = jnp.einsum('bnchk,bnchv->bnhkv', k_dec, v)
    a_chunk = jnp.exp(G_last)

    def step(S, inp):
        a, u = inp
        return a[..., None] * S + u, S

    s_fin, s_start = lax.scan(step, s0, (jnp.moveaxis(a_chunk, 1, 0), jnp.moveaxis(kv, 1, 0)))
    s_start = jnp.moveaxis(s_start, 0, 1)
    o_inter = jnp.einsum('bnchk,bnhkv->bnchv', q * jnp.exp(G), s_start)
    return (o_intra + o_inter).reshape(B, L, H, V), s_fin


def hgrn_bidir(P, s0_f, s0_b):
    o_f, s_f = hgrn_scan(P['hq'], P['k_f'], P['hv'], P['logf_f'], s0_f)
    rev = lambda a: a[:, ::-1]
    o_b, s_b = hgrn_scan(rev(P['hq']), rev(P['k_b']), rev(P['hv']), rev(P['logf_b']), s0_b)
    return o_f + rev(o_b), s_f, s_b


def hgrn_readout(o, gate, norm_w):
    B, L = o.shape[:2]
    return rmsnorm(o, norm_w).reshape(B, L, HG_WIDTH) * jax.nn.silu(gate)


def in_projection(h, w_in_l, q_norm_l, k_norm_l, lb_l, row=None, col=None):
    B, L, _ = h.shape
    (u_pool, q, k, v, hq, hi, zf_f, zf_b, hgate, g_pool, g_attn, g_hg) = jnp.split(h @ w_in_l, IN_SPLITS, axis=-1)
    q = rmsnorm(q.reshape(B, L, N_HEADS, HEAD_DIM), q_norm_l)
    k = rmsnorm(k.reshape(B, L, N_KV_HEADS, HEAD_DIM), k_norm_l)
    if row is not None:
        q = rope_2d(q, row, col)
        k = rope_2d(k, row, col)
    hs = lambda a: a.reshape(B, L, HG_HEADS, HG_DK)
    logf_f, k_f = _hgrn_gates(hs(zf_f), lb_l[0].reshape(HG_HEADS, HG_DK))
    logf_b, k_b = _hgrn_gates(hs(zf_b), lb_l[1].reshape(HG_HEADS, HG_DK))
    return {
        'pool': u_pool,
        'q': q.reshape(B, L, N_KV_HEADS, Q_PER_KV, HEAD_DIM),
        'k': k,
        'v': v.reshape(B, L, N_KV_HEADS, HEAD_DIM),
        'hq': hs(hq).astype(jnp.float32),
        'hv': hi.reshape(B, L, HG_HEADS, HG_DV),
        'logf_f': logf_f, 'k_f': k_f, 'logf_b': logf_b, 'k_b': k_b,
        'hgate': hgate, 'g_pool': g_pool, 'g_attn': g_attn, 'g_hg': g_hg,
    }


def merge_branches(P, pool_out, attn_out, hg_out, wbp, wba, wbh, wo):
    y = (jax.nn.sigmoid(P['g_pool']) * (pool_out @ wbp)
         + jax.nn.sigmoid(P['g_attn']) * (attn_out @ wba)
         + jax.nn.sigmoid(P['g_hg']) * (hg_out @ wbh))
    return y @ wo


def swiglu(h, w1, w2):
    a, b = jnp.split(h @ w1, 2, axis=-1)
    return (jax.nn.silu(a) * b) @ w2


def setup_inputs(seed: int = 0) -> dict:
    key = jax.random.key(seed)
    ks = jax.random.split(key, 24)
    f32 = jnp.float32
    nrm = lambda k, shape, s: jax.random.normal(k, shape, f32) * s
    return {
        'x': nrm(ks[0], (BATCH, SEQ, D_MODEL), 1.0),
        'c': nrm(ks[1], (BATCH, D_MODEL), 1.0),
        'ctx': nrm(ks[2], (BATCH, CTX_LEN, D_MODEL), 1.0),
        'c_ctx': nrm(ks[3], (D_MODEL,), 1.0),
        'w_ada': nrm(ks[4], (DEPTH, D_MODEL, N_MOD * D_MODEL), 0.5 * D_MODEL ** -0.5),
        'b_ada': nrm(ks[5], (DEPTH, N_MOD * D_MODEL), 0.01),
        'norm1_w': 1.0 + nrm(ks[6], (DEPTH, D_MODEL), 0.02),
        'w_in': nrm(ks[7], (DEPTH, D_MODEL, IN_WIDTH), D_MODEL ** -0.5),
        'pool_w': nrm(ks[8], (DEPTH, len(POOL_WINDOWS), POOL_GROUP, POOL_GROUP), POOL_GROUP ** -0.5),
        'pool_scale': 1.0 + nrm(ks[9], (DEPTH, POOL_WIDTH), 0.1),
        'q_norm_w': 1.0 + nrm(ks[10], (DEPTH, HEAD_DIM), 0.02),
        'k_norm_w': 1.0 + nrm(ks[11], (DEPTH, HEAD_DIM), 0.02),
        'hg_lb_logits': nrm(ks[12], (DEPTH, 2, HG_WIDTH), 0.5),
        'hg_norm_w': 1.0 + nrm(ks[13], (DEPTH, HG_DV), 0.02),
        'w_branch_pool': nrm(ks[14], (DEPTH, POOL_WIDTH, D_MODEL), POOL_WIDTH ** -0.5),
        'w_branch_attn': nrm(ks[15], (DEPTH, ATTN_WIDTH, D_MODEL), ATTN_WIDTH ** -0.5),
        'w_branch_hg': nrm(ks[16], (DEPTH, HG_WIDTH, D_MODEL), HG_WIDTH ** -0.5),
        'w_out': nrm(ks[17], (DEPTH, D_MODEL, D_MODEL), D_MODEL ** -0.5),
        'norm2_w': 1.0 + nrm(ks[18], (DEPTH, D_MODEL), 0.02),
        'w_ffn_in': nrm(ks[19], (DEPTH, D_MODEL, 2 * D_FF), D_MODEL ** -0.5),
        'w_ffn_out': nrm(ks[20], (DEPTH, D_FF, D_MODEL), D_FF ** -0.5),
    }


def reference(x, c, ctx, c_ctx, w_ada, b_ada, norm1_w, w_in, pool_w, pool_scale,
              q_norm_w, k_norm_w, hg_lb_logits, hg_norm_w, w_branch_pool, w_branch_attn,
              w_branch_hg, w_out, norm2_w, w_ffn_in, w_ffn_out):
    B, L, _ = x.shape
    ROWS = L // GRID_W
    row = jnp.repeat(jnp.arange(ROWS, dtype=jnp.int32), GRID_W)
    col = jnp.tile(jnp.arange(GRID_W, dtype=jnp.int32), ROWS)
    lb_cum = jnp.cumsum(jax.nn.softmax(hg_lb_logits.astype(jnp.float32), axis=0), axis=0)
    lb_all = lb_cum - lb_cum[0]
    c_act = jax.nn.silu(c)
    cc_act = jax.nn.silu(c_ctx)
    xc = ctx
    s_zero = jnp.zeros((B, HG_HEADS, HG_DK, HG_DV), jnp.float32)
    for l in range(DEPTH):
        sh1, sc1, g1, sh2, sc2, g2 = jnp.split((c_act @ w_ada[l] + b_ada[l])[:, None, :], N_MOD, axis=-1)
        sh1c, sc1c, g1c, sh2c, sc2c, g2c = jnp.split(cc_act @ w_ada[l] + b_ada[l], N_MOD, axis=-1)

        h = rmsnorm(x, norm1_w[l]) * (1.0 + sc1) + sh1
        hc = rmsnorm(xc, norm1_w[l]) * (1.0 + sc1c) + sh1c
        P = in_projection(h, w_in[l], q_norm_w[l], k_norm_w[l], lb_all[l], row, col)
        Pc = in_projection(hc, w_in[l], q_norm_w[l], k_norm_w[l], lb_all[l])

        o_hc, s_f, s_b = hgrn_bidir(Pc, s_zero, s_zero)
        o_hl, _, _ = hgrn_bidir(P, s_f, s_b)

        y_lat = merge_branches(
            P,
            pool_mix(P['pool'], pool_w[l], pool_scale[l]),
            latent_attention(P['q'], P['k'], P['v'], Pc['k'], Pc['v']),
            hgrn_readout(o_hl, P['hgate'], hg_norm_w[l]),
            w_branch_pool[l], w_branch_attn[l], w_branch_hg[l], w_out[l])
        x_new = x + g1 * y_lat

        if l < DEPTH - 1:
            Lc = xc.shape[1]
            y_ctx = merge_branches(
                Pc,
                pool_mix(Pc['pool'], pool_w[l], pool_scale[l]),
                _attend(Pc['q'], Pc['k'], Pc['v']).reshape(B, Lc, ATTN_WIDTH),
                hgrn_readout(o_hc, Pc['hgate'], hg_norm_w[l]),
                w_branch_pool[l], w_branch_attn[l], w_branch_hg[l], w_out[l])
            xc = xc + g1c * y_ctx
        x = x_new

        h2 = rmsnorm(x, norm2_w[l]) * (1.0 + sc2) + sh2
        x = x + g2 * swiglu(h2, w_ffn_in[l], w_ffn_out[l])
        if l < DEPTH - 1:
            h2c = rmsnorm(xc, norm2_w[l]) * (1.0 + sc2c) + sh2c
            xc = xc + g2c * swiglu(h2c, w_ffn_in[l], w_ffn_out[l])
    return x
```

```cpp
#include <hip/hip_runtime.h>
#include <hip/hip_cooperative_groups.h>
#include <cstdio>
#include <cstdint>
namespace cg = cooperative_groups;

#ifndef MK_MULTI
#define MK_MULTI 0
#endif

#ifndef ONLY
#define ONLY -1
#endif
#define ONLYP(k) (ONLY < 0 || ONLY == (k))
#define LAS __attribute__((address_space(3)))
#define GAS __attribute__((address_space(1)))
#define GIN(i) ((const GAS float*)a.in[i])
typedef unsigned short bf16_t;
typedef short bf16x8 __attribute__((ext_vector_type(8)));
typedef short s16x4 __attribute__((ext_vector_type(4)));
typedef float f32x2 __attribute__((ext_vector_type(2)));
typedef float f32x4 __attribute__((ext_vector_type(4)));
typedef float f32x16 __attribute__((ext_vector_type(16)));
typedef unsigned u32x2 __attribute__((ext_vector_type(2)));
typedef unsigned u32x4 __attribute__((ext_vector_type(4)));
typedef __bf16 bf16x2_t __attribute__((ext_vector_type(2)));

constexpr int D = 1024, NB = 8, SEQ = 2048, LCTX = 256, DEPTH = 4;
constexpr int ML = NB * SEQ, MC = NB * LCTX, MA = ML + MC;
constexpr int NIN = 5376, NP = 2304, NG = 3072, DFF = 2816, NFF = 5632;
constexpr int SKV = SEQ + LCTX;
constexpr float EPS = 1e-6f;
constexpr int PC_POOL = 0, PC_Q = 256, PC_K = 768, PC_V = 896, PC_HQ = 1024, PC_HI = 1280, PC_ZF = 1536, PC_ZB = 1792, PC_HG = 2048;
constexpr int MO_POOL = 0, MO_ATT = 256, MO_HG = 768;
constexpr int NCH = 36;

constexpr size_t MiB = 1u << 20;
constexpr size_t WS_CTL = 0;
constexpr size_t WS_NCNT = 65536;
constexpr size_t WS_XBUF = 262144;
constexpr size_t WS_BAR = 32768;
constexpr size_t WS_SM = 8192;
constexpr int SM_QNW = 0, SM_KNW = 256, SM_LB = 512, SM_HGNW = 2560, SM_N = 2816;
constexpr size_t WS_MODP = 1 * MiB;
constexpr size_t WS_MODF = 9 * MiB;
constexpr size_t WS_W = 10 * MiB;
constexpr size_t W_LAYER = 31 * MiB;
constexpr size_t WO_IN = 0, WO_MG = (size_t)NIN * D * 2, WO_O = WO_MG + (size_t)D * D * 2, WO_1 = WO_O + (size_t)D * D * 2, WO_2 = WO_1 + (size_t)NFF * D * 2;
static_assert(WO_2 + (size_t)D * DFF * 2 == W_LAYER, "weights per layer");
constexpr size_t WS_XC = WS_W + 4 * W_LAYER;
constexpr size_t WS_H = WS_XC + 8 * MiB;
constexpr size_t WS_PP = WS_H + 36 * MiB;
constexpr size_t WS_G = WS_PP + 81 * MiB;
constexpr size_t WS_MO = WS_G + 108 * MiB;
constexpr size_t WS_VT = WS_MO + 36 * MiB;
constexpr size_t WS_AV = WS_VT + 5 * MiB;
constexpr size_t WS_END = WS_AV + 1 * MiB;
constexpr int LDS_BYTES = 157696;
constexpr int NTHR = 512;
#define REPS {1, 1, 1, 1, 1, 1, 1, 1, 1, 1}
__device__ constexpr int REP_S[10] = REPS;

__device__ __forceinline__ float bf2f(bf16_t h) { return __uint_as_float((unsigned)h << 16); }
__device__ __forceinline__ unsigned f2bf(float f) { unsigned u = __float_as_uint(f); return (u + 0x7fffu + ((u >> 16) & 1u)) >> 16; }
__device__ __forceinline__ unsigned pk2(float lo, float hi) { f32x2 v = {lo, hi}; bf16x2_t b = __builtin_convertvector(v, bf16x2_t); return __builtin_bit_cast(unsigned, b); }
__device__ __forceinline__ float row16_sum(float v) {
    int x = __float_as_int(v);
    v += __int_as_float(__builtin_amdgcn_update_dpp(0, x, 0xB1, 0xF, 0xF, true)); x = __float_as_int(v);
    v += __int_as_float(__builtin_amdgcn_update_dpp(0, x, 0x4E, 0xF, 0xF, true)); x = __float_as_int(v);
    v += __int_as_float(__builtin_amdgcn_update_dpp(0, x, 0x124, 0xF, 0xF, true)); x = __float_as_int(v);
    v += __int_as_float(__builtin_amdgcn_update_dpp(0, x, 0x128, 0xF, 0xF, true));
    return v;
}
__device__ __forceinline__ float wave_sum(float v) {
    v = row16_sum(v);
    const int x = __float_as_int(v);
    return (__int_as_float(__builtin_amdgcn_readlane(x, 0)) + __int_as_float(__builtin_amdgcn_readlane(x, 16))) + (__int_as_float(__builtin_amdgcn_readlane(x, 32)) + __int_as_float(__builtin_amdgcn_readlane(x, 48)));
}
__device__ __forceinline__ float sigm(float x) { return __builtin_amdgcn_rcpf(1.f + __builtin_amdgcn_exp2f(x * -1.4426950408889634f)); }
__device__ __forceinline__ int tid_opq() { int t = threadIdx.x; asm volatile("" : "+v"(t)); return t; }
#if defined(__HIP_DEVICE_COMPILE__)
#define ASSUME_GLOBAL(p) __builtin_assume(!__builtin_amdgcn_is_shared((const void*)(p)) && !__builtin_amdgcn_is_private((const void*)(p)))
#else
#define ASSUME_GLOBAL(p) ((void)0)
#endif
#define LDS_WAIT() asm volatile("s_waitcnt lgkmcnt(0)" ::: "memory")

__device__ __forceinline__ float half_sum(float m);
namespace pg8 {
constexpr int BM = 256, BK = 64, HALF = 128, HTB = HALF * BK * 2, STAGE_BYTES = 8 * HTB, NXCD = 8, WGM = 8;
__host__ __device__ __forceinline__ int lds_byte(int r, int c) { const int st = (r >> 4) * 2 + (c >> 5), rr = r & 15, cc = c & 31, ob = rr * 64 + cc * 2; return st * 1024 + (ob ^ (((ob >> 9) & 1) << 5)); }
__host__ __device__ __forceinline__ void stage_rc(int b, int& R, int& C) { const int st = b / 1024, sb = b % 1024, swz = sb ^ (((sb >> 9) & 1) << 5); R = (st >> 1) * 16 + swz / 64; C = (st & 1) * 32 + (swz % 64) / 2; }
__host__ __device__ __forceinline__ int perm32(int rho) { const int n = rho >> 4, i = rho & 15; return 8 * (i >> 2) + 4 * n + (i & 3); }
struct Unit { int rt, pn, kt0, nkt, pass, half; };
struct Gemm { const GAS bf16_t* A; const GAS bf16_t* Bt; int M, N, K, lda, ldb; };
struct StaticOrder {
    int nM, nN, nwg, G, c, ntk, nhalf;
    __device__ void init(int M, int N, int G_, int c_, int ntk_, bool halfctx = false) {
        nN = N / BM; G = G_; c = c_; ntk = ntk_; nhalf = 0;
        if (halfctx && M > ML) { nM = ML / BM; nhalf = ((M - ML) / HALF) * nN; } else nM = M / BM;
        nwg = nM * nN;
    }
    __device__ void map(int wgid, Unit& u) const {
        u.half = 0;
        if (wgid >= nwg) { const int h = wgid - nwg; u.rt = ML / HALF + h / nN; u.pn = h % nN; u.half = 1; return; }
        { const int q = nwg / NXCD, r = nwg % NXCD, xcd = wgid % NXCD, off = wgid / NXCD; wgid = (xcd < r ? xcd * (q + 1) : r * (q + 1) + (xcd - r) * q) + off; }
        const int nig = WGM * nN, gid = wgid / nig, fm = gid * WGM, gsz = (nM - fm) < WGM ? (nM - fm) : WGM;
        u.rt = 2 * (fm + ((wgid % nig) % gsz)); u.pn = (wgid % nig) / gsz;
    }
    __device__ bool next(int i, Unit& u) const {
        const long L = (long)i * G + c; if (L >= nwg + nhalf) return false;
        map((int)L, u); u.kt0 = 0; u.nkt = ntk; u.pass = -1; return true;
    }
};
struct MergeOrder {
    StaticOrder so;
    __device__ void init(int M, int G_, int c_) { so.init(M, D, G_, c_, 16, true); }
    __device__ bool next(int i, Unit& u) const {
        const long L = (long)(i / 3) * so.G + so.c; if (L >= so.nwg + so.nhalf) return false;
        so.map((int)L, u); const int p = i % 3; u.pass = p; u.kt0 = p == 0 ? 0 : p == 1 ? 4 : 12; u.nkt = p == 1 ? 8 : 4; return true;
    }
};
template <class Epi, bool ALIGN_EPI, class Sched>
__device__ __forceinline__ void gemm_phase(LAS unsigned char* lds, const Gemm g, const Sched& S, const Epi& E) {
    const int tid = tid_opq(), wid = __builtin_amdgcn_readfirstlane(tid >> 6), lane = tid & 63, wr = wid >> 2, wc = wid & 3, fr = lane & 15, fq = lane >> 4;
    unsigned voffA[2], voffB[2];
#pragma unroll
    for (int i = 0; i < 2; ++i) { int R, C; stage_rc(tid * 16 + i * 8192, R, C); const int Rb = Epi::PERM ? ((R & ~31) + perm32(R & 31)) : R;
        voffA[i] = (unsigned)(R * g.lda + C) * 2u; voffB[i] = (unsigned)(Rb * g.ldb + C) * 2u; }
    const size_t kstep = (size_t)(BK * 2);
    const size_t hsA = (size_t)HALF * g.lda * 2, hsB = (size_t)HALF * g.ldb * 2;
    const size_t tsA = 2 * hsA, tsB = 2 * hsB;
    const unsigned ldsw = (unsigned)wid * 1024u;
    const int aoff = lds_byte(wr * 64 + fr, fq * 8), boff = lds_byte(wc * 32 + fr, fq * 8);
#define PG8_SA(b, h) (((b) * 2 + (h)) * HTB)
#define PG8_SB(b, h) ((4 + (b) * 2 + (h)) * HTB)
#define PG8_STAGE(bufoff, gbase, voff) do { _Pragma("unroll") for (int _i = 0; _i < 2; ++_i) \
        __builtin_amdgcn_global_load_lds((const GAS unsigned*)((const GAS char*)(gbase) + (voff)[_i]), (LAS unsigned*)(lds + (bufoff) + ldsw + _i * 8192), 16, 0, 0); } while (0)
#define PG8_LDA(dst, b, h) do { _Pragma("unroll") for (int m = 0; m < 4; ++m) _Pragma("unroll") for (int k = 0; k < 2; ++k) dst[m][k] = *(const LAS bf16x8*)(lds + PG8_SA(b, h) + aoff + m * 2048 + k * 1024); } while (0)
#define PG8_LDB(dst, b, h) do { _Pragma("unroll") for (int n = 0; n < 2; ++n) _Pragma("unroll") for (int k = 0; k < 2; ++k) dst[n][k] = *(const LAS bf16x8*)(lds + PG8_SB(b, h) + boff + n * 2048 + k * 1024); } while (0)
#define PG8_MMA(ai, bj, At, Bt) do { __builtin_amdgcn_s_setprio(1); _Pragma("unroll") for (int m = 0; m < 4; ++m) _Pragma("unroll") for (int n = 0; n < 2; ++n) _Pragma("unroll") for (int k = 0; k < 2; ++k) \
        acc[ai][bj][m][n] = __builtin_amdgcn_mfma_f32_16x16x32_bf16(Bt[n][k], At[m][k], acc[ai][bj][m][n], 0, 0, 0); __builtin_amdgcn_s_setprio(0); } while (0)
#define PG8_WAIT_V(n) asm volatile("s_waitcnt vmcnt(" #n ")" ::: "memory")
#define PG8_WAIT_L(n) asm volatile("s_waitcnt lgkmcnt(" #n ")" ::: "memory")
#define PG8_BAR __builtin_amdgcn_s_barrier()
#define PG8_SCHED __builtin_amdgcn_sched_barrier(0)
    Unit cur, nxt; int ui = 0;
    if (!S.next(0, cur)) return;
    f32x4 acc[2][2][4][2];
#pragma unroll
    for (int a = 0; a < 2; ++a)
#pragma unroll
        for (int b = 0; b < 2; ++b)
#pragma unroll
            for (int m = 0; m < 4; ++m)
#pragma unroll
                for (int n = 0; n < 2; ++n) acc[a][b][m][n] = (f32x4){0.f, 0.f, 0.f, 0.f};
    bf16x8 At[4][2], B0[2][2], B1[2][2];
    const GAS char* cA = (const GAS char*)g.A + (size_t)cur.rt * hsA + (size_t)cur.kt0 * kstep; const GAS char* cB = (const GAS char*)g.Bt + (size_t)cur.pn * tsB + (size_t)cur.kt0 * kstep;
    PG8_STAGE(PG8_SB(0, 0), cB, voffB); PG8_STAGE(PG8_SB(0, 1), cB + hsB, voffB); PG8_STAGE(PG8_SA(0, 0), cA, voffA); PG8_STAGE(PG8_SA(0, 1), cA + (cur.half ? 0 : hsA), voffA);
    if (wr == 1) PG8_BAR;
    PG8_WAIT_V(2); PG8_BAR;
    PG8_STAGE(PG8_SB(1, 0), cB + kstep, voffB); PG8_STAGE(PG8_SA(1, 0), cA + kstep, voffA); PG8_STAGE(PG8_SB(1, 1), cB + hsB + kstep, voffB);
    PG8_WAIT_V(6); PG8_BAR;
    for (;;) {
        const bool has_next = S.next(ui + 1, nxt);
        const GAS char* nA = has_next ? (const GAS char*)g.A + (size_t)nxt.rt * hsA + (size_t)nxt.kt0 * kstep : cA;
        const size_t hAc = cur.half ? 0 : hsA, hAn = has_next ? (nxt.half ? 0 : hsA) : hAc;
        const GAS char* nB = has_next ? (const GAS char*)g.Bt + (size_t)nxt.pn * tsB + (size_t)nxt.kt0 * kstep : cB;
        const int nt = cur.nkt;
        for (int t = 0; t < nt; t += 2) {
            const bool last = (t == nt - 2);
            const GAS char* a1 = cA + (size_t)(t + 1) * kstep;
            const GAS char* a2 = last ? nA : cA + (size_t)(t + 2) * kstep; const GAS char* b2 = last ? nB : cB + (size_t)(t + 2) * kstep;
            const GAS char* a3 = a2 + kstep; const GAS char* b3 = b2 + kstep;
            PG8_LDB(B0, 0, 0); PG8_LDB(B1, 0, 1); PG8_SCHED; PG8_LDA(At, 0, 0); PG8_STAGE(PG8_SA(1, 1), a1 + hAc, voffA);
            PG8_WAIT_V(8); PG8_WAIT_L(0); PG8_BAR; PG8_MMA(0, 0, At, B0); PG8_MMA(0, 1, At, B1); PG8_BAR; PG8_SCHED;
            PG8_LDA(At, 0, 1); PG8_STAGE(PG8_SB(0, 0), b2, voffB); PG8_STAGE(PG8_SB(0, 1), b2 + hsB, voffB); PG8_STAGE(PG8_SA(0, 0), a2, voffA);
            PG8_WAIT_V(8); PG8_WAIT_L(0); PG8_BAR; if (!cur.half) { PG8_MMA(1, 0, At, B0); PG8_MMA(1, 1, At, B1); } PG8_BAR; PG8_SCHED;
            PG8_LDB(B0, 1, 0); PG8_LDB(B1, 1, 1); PG8_SCHED; PG8_LDA(At, 1, 0); PG8_STAGE(PG8_SA(0, 1), a2 + (last ? hAn : hAc), voffA);
            PG8_WAIT_V(8); PG8_WAIT_L(0); PG8_BAR; PG8_MMA(0, 0, At, B0); PG8_MMA(0, 1, At, B1); PG8_BAR; PG8_SCHED;
            PG8_LDA(At, 1, 1); PG8_STAGE(PG8_SB(1, 0), b3, voffB); PG8_STAGE(PG8_SB(1, 1), b3 + hsB, voffB); PG8_STAGE(PG8_SA(1, 0), a3, voffA);
            PG8_WAIT_V(8); PG8_WAIT_L(0); PG8_BAR; if (!cur.half) { PG8_MMA(1, 0, At, B0); PG8_MMA(1, 1, At, B1); } PG8_BAR; PG8_SCHED;
        }
        if constexpr (ALIGN_EPI) { if (wr == 0) PG8_BAR; }
        E(acc, cur, wr, wc, fr, fq);
        if (!has_next) break;
        if (Epi::zero_after(cur))
#pragma unroll
        for (int a = 0; a < 2; ++a)
#pragma unroll
            for (int b = 0; b < 2; ++b)
#pragma unroll
                for (int m = 0; m < 4; ++m)
#pragma unroll
                    for (int n = 0; n < 2; ++n) acc[a][b][m][n] = (f32x4){0.f, 0.f, 0.f, 0.f};
        cur = nxt; cA = nA; cB = nB; ++ui;
        if constexpr (ALIGN_EPI) { if (wr == 1) PG8_BAR; }
    }
    PG8_WAIT_V(0);
    if constexpr (!ALIGN_EPI) { if (wr == 0) PG8_BAR; }
    PG8_BAR;
#undef PG8_SA
#undef PG8_SB
#undef PG8_STAGE
#undef PG8_LDA
#undef PG8_LDB
#undef PG8_MMA
#undef PG8_WAIT_V
#undef PG8_WAIT_L
#undef PG8_BAR
#undef PG8_SCHED
}

typedef f32x4 (&AccRef)[2][2][4][2];
struct EpiInProj {
    static constexpr bool PERM = true;
    __device__ static __forceinline__ bool zero_after(const Unit&) { return true; }
    GAS bf16_t* Pp; GAS bf16_t* G;
    __device__ __forceinline__ void operator()(AccRef acc, const Unit& u, int wr, int wc, int fr, int fq) const {
        const bool gate = u.pn >= 9;
        GAS bf16_t* base = gate ? G : Pp; const int ld = gate ? NG : NP; const int colt = gate ? (u.pn - 9) * BM : u.pn * BM;
        const int row0 = u.rt * HALF + wr * 64 + fr, col0 = colt + wc * 32 + 8 * fq;
#pragma unroll
        for (int ai = 0; ai < 2; ++ai)
#pragma unroll
            for (int m = 0; m < 4; ++m) { GAS bf16_t* rowp = base + (size_t)(row0 + ai * HALF + m * 16) * ld + col0;
#pragma unroll
                for (int bj = 0; bj < 2; ++bj) { f32x4 v0 = acc[ai][bj][m][0], v1 = acc[ai][bj][m][1];
                    if (gate) { v0 = (f32x4){sigm(v0[0]), sigm(v0[1]), sigm(v0[2]), sigm(v0[3])}; v1 = (f32x4){sigm(v1[0]), sigm(v1[1]), sigm(v1[2]), sigm(v1[3])}; }
                    u32x4 w; w.x = pk2(v0[0], v0[1]); w.y = pk2(v0[2], v0[3]); w.z = pk2(v1[0], v1[1]); w.w = pk2(v1[2], v1[3]);
                    *(GAS u32x4*)(rowp + bj * HALF) = w; } }
    }
};
struct EpiMerge {
    static constexpr bool PERM = true;
    const GAS bf16_t* G; GAS bf16_t* Yb;
    __device__ static __forceinline__ bool zero_after(const Unit& u) { return u.pass == 2; }
    __device__ __forceinline__ void operator()(AccRef acc, const Unit& u, int wr, int wc, int fr, int fq) const {
        const int row0 = u.rt * HALF + wr * 64 + fr, col0 = u.pn * BM + wc * 32 + 8 * fq, P = u.pass;
        const GAS bf16_t* gp = G + (size_t)row0 * NG + P * D + col0;
        u32x4 gb[2][2], hb[2][2];
#pragma unroll
        for (int bj = 0; bj < 2; ++bj) { gb[0][bj] = *(const GAS u32x4*)(gp + bj * HALF); if (P < 2) hb[0][bj] = *(const GAS u32x4*)(gp + D + bj * HALF); }
#pragma unroll
        for (int gi = 0; gi < 8; ++gi) {
            const int ai = gi >> 2, m = gi & 3, cb = gi & 1, nb = cb ^ 1;
            if (u.half && gi >= 4) break;
            if (gi < 7 && !(u.half && gi >= 3)) { const int ai2 = (gi + 1) >> 2, m2 = (gi + 1) & 3; const GAS bf16_t* q = gp + (size_t)(ai2 * HALF + m2 * 16) * NG;
#pragma unroll
                for (int bj = 0; bj < 2; ++bj) { gb[nb][bj] = *(const GAS u32x4*)(q + bj * HALF); if (P < 2) hb[nb][bj] = *(const GAS u32x4*)(q + D + bj * HALF); } }
            const size_t row = (size_t)(row0 + ai * HALF + m * 16);
#pragma unroll
            for (int bj = 0; bj < 2; ++bj) { const int col = col0 + bj * HALF;
                const u32x4 gw = gb[cb][bj];
                f32x4 g0 = {__uint_as_float(gw.x << 16), __uint_as_float(gw.x & 0xffff0000u), __uint_as_float(gw.y << 16), __uint_as_float(gw.y & 0xffff0000u)};
                f32x4 g1 = {__uint_as_float(gw.z << 16), __uint_as_float(gw.z & 0xffff0000u), __uint_as_float(gw.w << 16), __uint_as_float(gw.w & 0xffff0000u)};
                if (P < 2) {
                    const u32x4 hw = hb[cb][bj];
                    const f32x4 h0 = {__uint_as_float(hw.x << 16), __uint_as_float(hw.x & 0xffff0000u), __uint_as_float(hw.y << 16), __uint_as_float(hw.y & 0xffff0000u)};
                    const f32x4 h1 = {__uint_as_float(hw.z << 16), __uint_as_float(hw.z & 0xffff0000u), __uint_as_float(hw.w << 16), __uint_as_float(hw.w & 0xffff0000u)};
#pragma unroll
                    for (int i = 0; i < 4; ++i) { acc[ai][bj][m][0][i] *= g0[i] * __builtin_amdgcn_rcpf(fmaxf(h0[i], 1e-30f)); acc[ai][bj][m][1][i] *= g1[i] * __builtin_amdgcn_rcpf(fmaxf(h1[i], 1e-30f)); }
                } else {
                    const f32x4 y0 = g0 * acc[ai][bj][m][0], y1 = g1 * acc[ai][bj][m][1];
                    u32x4 w; w.x = pk2(y0[0], y0[1]); w.y = pk2(y0[2], y0[3]); w.z = pk2(y1[0], y1[1]); w.w = pk2(y1[2], y1[3]); *(GAS u32x4*)(Yb + row * D + col) = w;
                }
            }
            asm volatile("" ::: "memory");
        }
    }
};
struct EpiResid {
    static constexpr bool PERM = false;
    __device__ static __forceinline__ bool zero_after(const Unit&) { return true; }
    const GAS float* baseL; const GAS float* baseC; GAS float* outL; GAS float* outC; const GAS float* gv;
    __device__ __forceinline__ void operator()(AccRef acc, const Unit& u, int wr, int wc, int fr, int fq) const {
        const bool lat = u.rt < ML / HALF;
        const int bb = lat ? (u.rt >> 4) : 8;
        const int r0 = (lat ? u.rt * HALF : u.rt * HALF - ML) + wr * 64 + fr;
        const GAS float* base = lat ? baseL : baseC; GAS float* out = lat ? outL : outC;
        const int col0 = u.pn * BM + wc * 32 + 4 * fq;
        f32x4 g[2][2];
#pragma unroll
        for (int bj = 0; bj < 2; ++bj)
#pragma unroll
            for (int n = 0; n < 2; ++n) g[bj][n] = *(const GAS f32x4*)(gv + (size_t)bb * 6 * D + col0 + bj * HALF + n * 16);
        const GAS float* bp = base + (size_t)r0 * D + col0;
        f32x4 rb[2][2][2];
#pragma unroll
        for (int bj = 0; bj < 2; ++bj)
#pragma unroll
            for (int n = 0; n < 2; ++n) rb[0][bj][n] = *(const GAS f32x4*)(bp + bj * HALF + n * 16);
#pragma unroll
        for (int gi = 0; gi < 8; ++gi) {
            const int ai = gi >> 2, m = gi & 3, cb = gi & 1, nb = cb ^ 1;
            if (u.half && gi >= 4) break;
            if (gi < 7 && !(u.half && gi >= 3)) { const int ai2 = (gi + 1) >> 2, m2 = (gi + 1) & 3; const GAS float* q = bp + (size_t)(ai2 * HALF + m2 * 16) * D;
#pragma unroll
                for (int bj = 0; bj < 2; ++bj)
#pragma unroll
                    for (int n = 0; n < 2; ++n) rb[nb][bj][n] = *(const GAS f32x4*)(q + bj * HALF + n * 16); }
            const size_t off = (size_t)(r0 + ai * HALF + m * 16) * D + col0;
#pragma unroll
            for (int bj = 0; bj < 2; ++bj)
#pragma unroll
                for (int n = 0; n < 2; ++n) *(GAS f32x4*)(out + off + bj * HALF + n * 16) = rb[cb][bj][n] + g[bj][n] * acc[ai][bj][m][n];
            asm volatile("" ::: "memory");
        }
    }
};
struct EpiResidNorm {
    static constexpr bool PERM = false;
    __device__ static __forceinline__ bool zero_after(const Unit&) { return true; }
    const GAS float* baseL; const GAS float* baseC; GAS float* outL; GAS float* outC; const GAS float* gv;
    const GAS float* nsc; const GAS float* nsh; GAS bf16_t* Hn; GAS unsigned* cnt; GAS unsigned* xbuf; LAS unsigned char* xl;
    __device__ __forceinline__ void operator()(AccRef acc, const Unit& u, int wr, int wc, int fr, int fq) const {
        const bool lat = u.rt < ML / HALF;
        const int bb = lat ? (u.rt >> 4) : 8;
        const int r0 = (lat ? u.rt * HALF : u.rt * HALF - ML) + wr * 64 + fr;
        const GAS float* base = lat ? baseL : baseC; GAS float* out = lat ? outL : outC;
        const int col0 = u.pn * BM + wc * 32 + 4 * fq;
        const int ngr = u.half ? 4 : 8, nrows = u.half ? HALF : BM;
        LAS float* P = (LAS float*)xl; LAS float* S = (LAS float*)(xl + 4096);
        {
            f32x4 g[2][2];
#pragma unroll
            for (int bj = 0; bj < 2; ++bj)
#pragma unroll
                for (int n = 0; n < 2; ++n) g[bj][n] = *(const GAS f32x4*)(gv + (size_t)bb * 6 * D + col0 + bj * HALF + n * 16);
            const GAS float* bp = base + (size_t)r0 * D + col0;
            f32x4 rb[2][2][2];
#pragma unroll
            for (int bj = 0; bj < 2; ++bj)
#pragma unroll
                for (int n = 0; n < 2; ++n) rb[0][bj][n] = *(const GAS f32x4*)(bp + bj * HALF + n * 16);
#pragma unroll
            for (int gi = 0; gi < 8; ++gi) {
                const int ai = gi >> 2, m = gi & 3, cb = gi & 1, nb = cb ^ 1;
                if (gi >= ngr) break;
                if (gi + 1 < ngr) { const int ai2 = (gi + 1) >> 2, m2 = (gi + 1) & 3; const GAS float* q = bp + (size_t)(ai2 * HALF + m2 * 16) * D;
#pragma unroll
                    for (int bj = 0; bj < 2; ++bj)
#pragma unroll
                        for (int n = 0; n < 2; ++n) rb[nb][bj][n] = *(const GAS f32x4*)(q + bj * HALF + n * 16); }
                float ss = 0.f;
#pragma unroll
                for (int bj = 0; bj < 2; ++bj)
#pragma unroll
                    for (int n = 0; n < 2; ++n) { const f32x4 x1 = rb[cb][bj][n] + g[bj][n] * acc[ai][bj][m][n]; acc[ai][bj][m][n] = x1;
                        ss += (x1.x * x1.x + x1.y * x1.y) + (x1.z * x1.z + x1.w * x1.w); }
                ss += __int_as_float(__builtin_amdgcn_ds_swizzle(__float_as_int(ss), 0x401F));
                ss = half_sum(ss);
                if (fq == 0) P[(ai * HALF + wr * 64 + m * 16 + fr) * 4 + wc] = ss;
                asm volatile("" ::: "memory");
            }
        }
        const int tid = (wr * 4 + wc) * 64 + fq * 16 + fr;
        const size_t grow0 = (size_t)u.rt * HALF;
        asm volatile("s_waitcnt lgkmcnt(0)" ::: "memory"); __builtin_amdgcn_s_barrier(); asm volatile("" ::: "memory");
        if (tid < nrows) { const f32x4 p4 = *(const LAS f32x4*)(P + tid * 4); const float tot = (p4.x + p4.y) + (p4.z + p4.w);
            __hip_atomic_store((unsigned*)(xbuf + (grow0 + tid) * 4 + u.pn), __float_as_uint(tot), __ATOMIC_RELAXED, __HIP_MEMORY_SCOPE_AGENT); }
        asm volatile("s_waitcnt vmcnt(0)" ::: "memory");
        unsigned* cp = (unsigned*)(cnt + u.rt * 16);
        if ((fq | fr) == 0) (void)__hip_atomic_fetch_add(cp, 1u, __ATOMIC_RELAXED, __HIP_MEMORY_SCOPE_AGENT);
        f32x4 nscv[2][2], nshv[2][2];
#pragma unroll
        for (int bj = 0; bj < 2; ++bj)
#pragma unroll
            for (int n = 0; n < 2; ++n) { nscv[bj][n] = *(const GAS f32x4*)(nsc + (size_t)bb * 6 * D + col0 + bj * HALF + n * 16); nshv[bj][n] = *(const GAS f32x4*)(nsh + (size_t)bb * 6 * D + col0 + bj * HALF + n * 16); }
        if (tid < 64) { unsigned sp = 0;
            while ((unsigned)__builtin_amdgcn_readfirstlane(__hip_atomic_load(cp, __ATOMIC_RELAXED, __HIP_MEMORY_SCOPE_AGENT)) < 32u && ++sp < (1u << 20)) __builtin_amdgcn_s_sleep(1);
            }
        asm volatile("s_waitcnt vmcnt(0) lgkmcnt(0)" ::: "memory"); __builtin_amdgcn_s_barrier(); asm volatile("" ::: "memory");
        if (tid < nrows) { const unsigned* sl = (const unsigned*)(xbuf + (grow0 + tid) * 4); float tot = 0.f;
#pragma unroll
            for (int t = 0; t < 4; ++t) tot += __uint_as_float(__hip_atomic_load(sl + t, __ATOMIC_RELAXED, __HIP_MEMORY_SCOPE_AGENT));
            S[tid] = __builtin_amdgcn_rsqf(tot * (1.f / D) + EPS); }
        asm volatile("s_waitcnt vmcnt(0) lgkmcnt(0)" ::: "memory"); __builtin_amdgcn_s_barrier(); asm volatile("" ::: "memory");
#pragma unroll
        for (int gi = 0; gi < 8; ++gi) {
            const int ai = gi >> 2, m = gi & 3;
            if (gi >= ngr) break;
            const int lr = ai * HALF + wr * 64 + m * 16 + fr;
            const float rs = S[lr];
            GAS bf16_t* hp = Hn + (grow0 + lr) * D + col0;
            GAS float* op = out + (size_t)(r0 + ai * HALF + m * 16) * D + col0;
#pragma unroll
            for (int bj = 0; bj < 2; ++bj)
#pragma unroll
                for (int n = 0; n < 2; ++n) { const f32x4 x1 = acc[ai][bj][m][n];
                    *(GAS f32x4*)(op + bj * HALF + n * 16) = x1;
                    const f32x4 h = x1 * rs * nscv[bj][n] + nshv[bj][n]; u32x2 w; w.x = pk2(h.x, h.y); w.y = pk2(h.z, h.w); *(GAS u32x2*)(hp + bj * HALF + n * 16) = w; }
        }
    }
};
struct EpiSwiglu {
    static constexpr bool PERM = true;
    __device__ static __forceinline__ bool zero_after(const Unit&) { return true; }
    GAS bf16_t* Hd;
    __device__ __forceinline__ void operator()(AccRef acc, const Unit& u, int wr, int wc, int fr, int fq) const {
        const int row0 = u.rt * HALF + wr * 64 + fr, col0 = u.pn * HALF + wc * 32 + 8 * fq;
#pragma unroll
        for (int ai = 0; ai < 2; ++ai)
#pragma unroll
            for (int m = 0; m < 4; ++m) { const size_t row = (size_t)(row0 + ai * HALF + m * 16);
                float o[8];
#pragma unroll
                for (int n = 0; n < 2; ++n)
#pragma unroll
                    for (int i = 0; i < 4; ++i) { const float a = acc[ai][0][m][n][i], b = acc[ai][1][m][n][i]; o[n * 4 + i] = a * sigm(a) * b; }
                u32x4 w; w.x = pk2(o[0], o[1]); w.y = pk2(o[2], o[3]); w.z = pk2(o[4], o[5]); w.w = pk2(o[6], o[7]);
                *(GAS u32x4*)(Hd + row * DFF + col0) = w; }
    }
};
}

struct Args { const float* in[21]; float* out; unsigned char* ws; int ph_lo, ph_hi; };
enum { I_X = 0, I_C, I_CTX, I_CCTX, I_WADA, I_BADA, I_N1W, I_WIN, I_POOLW, I_POOLS, I_QNW, I_KNW, I_LB, I_HGNW, I_WBP, I_WBA, I_WBH, I_WOUT, I_N2W, I_W1, I_W2 };

__device__ __forceinline__ void transpose_item(const GAS float* W, int N, GAS bf16_t* WT, int ldt, int koff, int mode, LAS float* scr, int kb, int nb, int lane) {
    const int k0 = 64 * kb, n0 = 32 * nb;
#pragma unroll 8
    for (int i = 0; i < 32; ++i) { const int kk = 2 * i + (lane >> 5); scr[kk * 33 + (lane & 31)] = W[(size_t)(k0 + kk) * N + n0 + (lane & 31)]; }
    LDS_WAIT();
    const int c = lane & 7;
#pragma unroll
    for (int j = 0; j < 4; ++j) { const int n = (lane >> 3) + 8 * j; const LAS float* s = scr + (8 * c) * 33 + n;
        u32x4 o; o.x = pk2(s[0 * 33], s[1 * 33]); o.y = pk2(s[2 * 33], s[3 * 33]); o.z = pk2(s[4 * 33], s[5 * 33]); o.w = pk2(s[6 * 33], s[7 * 33]);
        const int nn = n0 + n; int drow = nn;
        if (mode == 1) { const int half = nn >= DFF ? 1 : 0; const int n2 = nn - half * DFF; drow = (n2 >> 7) * 256 + half * 128 + (n2 & 127); }
        *(GAS u32x4*)(WT + (size_t)drow * ldt + koff + k0 + 8 * c) = o; }
    LDS_WAIT();
}

__device__ __forceinline__ void convert_layer(const Args& a, LAS unsigned char* lds, int l, int gw, int NGW, int part, int nparts) {
    const int tid = tid_opq(), lane = tid & 63, wid = tid >> 6;
    GAS unsigned char* ws = (GAS unsigned char*)a.ws;
    LAS float* scr = (LAS float*)(lds + wid * 8448);
    GAS unsigned char* wl = ws + WS_W + l * W_LAYER;
    for (int it = gw * nparts + part; it < 7808; it += NGW * nparts) {
        int r = it;
        if (r < 2688) { transpose_item(GIN(I_WIN) + (size_t)l * D * NIN, NIN, (GAS bf16_t*)(wl + WO_IN), D, 0, 0, scr, r / 168, r % 168, lane); continue; } r -= 2688;
        if (r < 256) { transpose_item(GIN(I_WBA) + (size_t)l * 512 * D, D, (GAS bf16_t*)(wl + WO_MG), D, 256, 0, scr, r / 32, r % 32, lane); continue; } r -= 256;
        if (r < 128) { transpose_item(GIN(I_WBH) + (size_t)l * 256 * D, D, (GAS bf16_t*)(wl + WO_MG), D, 768, 0, scr, r / 32, r % 32, lane); continue; } r -= 128;
        if (r < 512) { transpose_item(GIN(I_WOUT) + (size_t)l * D * D, D, (GAS bf16_t*)(wl + WO_O), D, 0, 0, scr, r / 32, r % 32, lane); continue; } r -= 512;
        if (r < 2816) { transpose_item(GIN(I_W1) + (size_t)l * D * NFF, NFF, (GAS bf16_t*)(wl + WO_1), D, 0, 1, scr, r / 176, r % 176, lane); continue; } r -= 2816;
        transpose_item(GIN(I_W2) + (size_t)l * DFF * D, D, (GAS bf16_t*)(wl + WO_2), DFF, 0, 0, scr, r / 32, r % 32, lane);
    }
}

__device__ __forceinline__ void phase_prologue(const Args& a, LAS unsigned char* lds, int G) {
    const int tid = tid_opq(), lane = tid & 63, wid = tid >> 6;
    GAS unsigned char* ws = ((GAS unsigned char*)a.ws); ASSUME_GLOBAL(ws); ASSUME_GLOBAL(((GAS float*)a.out));
#pragma unroll
    for (int i = 0; i < 21; ++i) ASSUME_GLOBAL(GIN(i));
    LAS float* sa = (LAS float*)(lds + 73728);
    for (int i = tid; i < 9 * D; i += NTHR) { const float v = i < 8 * D ? GIN(I_C)[i] : GIN(I_CCTX)[i - 8 * D]; sa[i] = v * sigm(v); }
    __syncthreads();
    {
        GAS float* modp = (GAS float*)(ws + WS_MODP);
        for (int idx = blockIdx.x * NTHR + tid; idx < 8 * 4 * 3072; idx += G * NTHR) {
            const int j = 2 * (idx % 3072), l = (idx / 3072) & 3, ks = idx / (3072 * 4);
            const GAS float* w = GIN(I_WADA) + ((size_t)l * D + ks * 128) * 6144 + j;
            f32x2 acc[9];
#pragma unroll
            for (int b = 0; b < 9; ++b) acc[b] = (f32x2){0.f, 0.f};
#pragma unroll 8
            for (int k = 0; k < 128; ++k) { const f32x2 wv = *(const GAS f32x2*)(w + (size_t)k * 6144);
#pragma unroll
                for (int b = 0; b < 9; ++b) acc[b] += wv * sa[b * D + ks * 128 + k]; }
#pragma unroll
            for (int b = 0; b < 9; ++b) *(GAS f32x2*)(modp + ((size_t)(ks * 4 + l) * 9 + b) * 6144 + j) = acc[b];
        }
    }
    for (int idx = blockIdx.x * NTHR + tid; idx < 4 * 32 * 1024; idx += G * NTHR) {
        const int n = idx & 1023, hi = __builtin_amdgcn_readfirstlane(idx >> 10), c8 = hi & 31, l = hi >> 5, g = c8 >> 3;
        const GAS float* pw = GIN(I_POOLW) + ((size_t)l * 256 + 8 * c8) * 64;
        const GAS float* ps = GIN(I_POOLS) + l * 256 + g * 64;
        const GAS float* wb = GIN(I_WBP) + ((size_t)l * 256 + g * 64) * D + n;
        float sacc[8];
#pragma unroll
        for (int j = 0; j < 8; ++j) sacc[j] = 0.f;
#pragma unroll 16
        for (int d = 0; d < 64; ++d) { const float x = ps[d] * wb[(size_t)d * D];
#pragma unroll
            for (int j = 0; j < 8; ++j) sacc[j] += pw[j * 64 + d] * x; }
        GAS bf16_t* wt = (GAS bf16_t*)(ws + WS_W + l * W_LAYER + WO_MG);
        u32x4 o; o.x = pk2(sacc[0], sacc[1]); o.y = pk2(sacc[2], sacc[3]); o.z = pk2(sacc[4], sacc[5]); o.w = pk2(sacc[6], sacc[7]);
        *(GAS u32x4*)(wt + (size_t)n * D + 8 * c8) = o;
    }
    {
        GAS float* sm = (GAS float*)(ws + WS_SM);
        if (blockIdx.x == 0) for (int i = tid; i < SM_N; i += NTHR)
            sm[i] = i < SM_KNW ? GIN(I_QNW)[i] : i < SM_LB ? GIN(I_KNW)[i - SM_KNW] : i < SM_HGNW ? GIN(I_LB)[i - SM_LB] : GIN(I_HGNW)[i - SM_HGNW];
    }
    convert_layer(a, lds, 0, blockIdx.x * 8 + wid, G * 8, 0, 1);
}

__device__ __forceinline__ void phase_modfinal(const Args& a, int G) {
    ASSUME_GLOBAL(((GAS unsigned char*)a.ws)); ASSUME_GLOBAL(GIN(I_BADA)); ASSUME_GLOBAL(GIN(I_N1W)); ASSUME_GLOBAL(GIN(I_N2W));
    const GAS float* modp = (const GAS float*)(((GAS unsigned char*)a.ws) + WS_MODP); GAS float* modf = (GAS float*)(((GAS unsigned char*)a.ws) + WS_MODF);
    const int tid = tid_opq();
    for (int idx = blockIdx.x * NTHR + tid; idx < 4 * 9 * 6144; idx += G * NTHR) {
        const int j = idx % 6144, b = (idx / 6144) % 9, l = idx / (6144 * 9), s = j >> 10, i = j & 1023;
        float v = GIN(I_BADA)[l * 6144 + j];
#pragma unroll
        for (int ks = 0; ks < 8; ++ks) v += modp[((size_t)(ks * 4 + l) * 9 + b) * 6144 + j];
        if (s == 1) v = GIN(I_N1W)[l * D + i] * (1.f + v);
        if (s == 4) v = GIN(I_N2W)[l * D + i] * (1.f + v);
        modf[idx] = v;
    }
}

__device__ __forceinline__ void phase_norm(const GAS float* srcL, const GAS float* srcC, GAS bf16_t* H, const GAS float* modf_l, int s_scale, int s_shift, int M, int G) {
    const int tid = tid_opq(), lane = tid & 63, wid = tid >> 6;
    int row = wid * G + blockIdx.x;
    if (row >= M) return;
    f32x4 v[4];
    { const GAS float* xr = row < ML ? srcL + (size_t)row * D : srcC + (size_t)(row - ML) * D;
#pragma unroll
      for (int j = 0; j < 4; ++j) v[j] = ((const GAS f32x4*)xr)[lane + 64 * j]; }
    for (;;) {
        const int nrow = row + G * 8; const bool more = nrow < M;
        f32x4 vn[4];
        if (more) { const GAS float* xr = nrow < ML ? srcL + (size_t)nrow * D : srcC + (size_t)(nrow - ML) * D;
#pragma unroll
            for (int j = 0; j < 4; ++j) vn[j] = ((const GAS f32x4*)xr)[lane + 64 * j]; }
        const int bb = row < ML ? (row >> 11) : 8;
        const GAS f32x4* sc = (const GAS f32x4*)(modf_l + (size_t)(bb * 6 + s_scale) * D); const GAS f32x4* sh = (const GAS f32x4*)(modf_l + (size_t)(bb * 6 + s_shift) * D);
        f32x4 scv[4], shv[4];
#pragma unroll
        for (int j = 0; j < 4; ++j) { scv[j] = sc[lane + 64 * j]; shv[j] = sh[lane + 64 * j]; }
        float ss = 0.f;
#pragma unroll
        for (int j = 0; j < 4; ++j) ss += (v[j].x * v[j].x + v[j].y * v[j].y) + (v[j].z * v[j].z + v[j].w * v[j].w);
        const float r = __builtin_amdgcn_rsqf(wave_sum(ss) * (1.f / D) + EPS);
        GAS u32x2* o = (GAS u32x2*)(H + (size_t)row * D);
#pragma unroll
        for (int j = 0; j < 4; ++j) { const f32x4 y = v[j] * r * scv[j] + shv[j]; u32x2 w; w.x = pk2(y.x, y.y); w.y = pk2(y.z, y.w); o[lane + 64 * j] = w; }
        if (!more) break;
#pragma unroll
        for (int j = 0; j < 4; ++j) v[j] = vn[j];
        row = nrow;
    }
}

__device__ __forceinline__ float half_max(float m) { auto rr = __builtin_amdgcn_permlane32_swap(__float_as_uint(m), __float_as_uint(m), false, false); return fmaxf(__uint_as_float(rr[0]), __uint_as_float(rr[1])); }
__device__ __forceinline__ float half_sum(float m) { auto rr = __builtin_amdgcn_permlane32_swap(__float_as_uint(m), __float_as_uint(m), false, false); return __uint_as_float(rr[0]) + __uint_as_float(rr[1]); }
constexpr int HG_WL = 19712, HQ_OFF = 0, HK_OFF = 4608, HKH_OFF = 9216, HVT_OFF = 14336, HDEC_OFF = 19456;
#define MFMA32(a, b, c) __builtin_amdgcn_mfma_f32_32x32x16_bf16((a), (b), (c), 0, 0, 0)
__device__ __forceinline__ float hgrn_lb(const GAS float* lbl, int l, int dir, int col) {
    float x[4]; float mx = -1e30f;
#pragma unroll
    for (int i = 0; i < 4; ++i) { x[i] = lbl[(i * 2 + dir) * 256 + col]; mx = fmaxf(mx, x[i]); }
    float e[4], s = 0.f;
#pragma unroll
    for (int i = 0; i < 4; ++i) { e[i] = __expf(x[i] - mx); s += e[i]; }
    float c = 0.f;
#pragma unroll
    for (int i = 1; i < 4; ++i) if (i <= l) c += e[i];
    return c / s;
}
__device__ __forceinline__ bf16x8 pack8(const f32x16& x, int base) {
    u32x4 w; w.x = pk2(x[base], x[base + 1]); w.y = pk2(x[base + 2], x[base + 3]); w.z = pk2(x[base + 4], x[base + 5]); w.w = pk2(x[base + 6], x[base + 7]);
    return __builtin_bit_cast(bf16x8, w);
}
template <int DIR, bool FULL>
__device__ __forceinline__ float hg_prep(LAS unsigned char* wl, const GAS bf16_t* Pp, size_t row0, int hd, float lb, int lane) {
    const GAS bf16_t* pz = Pp + row0 * NP + (DIR ? PC_ZB : PC_ZF) + hd * 64 + lane;
    const GAS bf16_t* pq = Pp + row0 * NP + PC_HQ + hd * 64 + lane;
    const GAS bf16_t* pv = Pp + row0 * NP + PC_HI + hd * 64 + lane;
    unsigned vp[16];
#pragma unroll
    for (int c = 0; c < 16; ++c) vp[c] = (unsigned)pv[(size_t)(2 * c) * NP] | ((unsigned)pv[(size_t)(2 * c + 1) * NP] << 16);
    unsigned ktp[16]; float Dc = 1.f;
#pragma unroll
    for (int i = 0; i < 16; ++i) ktp[i] = 0u;
    bf16_t zr[2][8], qr[2][8];
#pragma unroll
    for (int i = 0; i < 8; ++i) { const int t = DIR ? 31 - i : i; zr[0][i] = pz[(size_t)t * NP]; if (FULL) qr[0][i] = pq[(size_t)t * NP]; }
#pragma unroll
    for (int g = 0; g < 4; ++g) {
        if (g < 3) {
#pragma unroll
            for (int i = 0; i < 8; ++i) { const int t = DIR ? 31 - (8 * (g + 1) + i) : 8 * (g + 1) + i; zr[(g + 1) & 1][i] = pz[(size_t)t * NP]; if (FULL) qr[(g + 1) & 1][i] = pq[(size_t)t * NP]; }
        }
#pragma unroll
        for (int i = 0; i < 8; ++i) {
            const int t = DIR ? 31 - (8 * g + i) : 8 * g + i;
            float z = bf2f(zr[g & 1][i]); z = fminf(fmaxf(z, -30.f), 30.f);
            const float e = __builtin_amdgcn_exp2f(z * -1.4426950408889634f); const float sg = __builtin_amdgcn_rcpf(1.f + e);
            const float f = lb + (1.f - lb) * sg; const float kkv = (1.f - lb) * (e * sg);
            Dc = fmaxf(Dc * f, 1e-30f);
            const float kti = kkv * __builtin_amdgcn_rcpf(Dc);
            const unsigned ktb = f2bf(kti); ktp[t >> 1] |= (t & 1) ? (ktb << 16) : ktb;
            if (FULL) { const float q = bf2f(qr[g & 1][i]);
                *(LAS bf16_t*)(wl + HQ_OFF + t * 144 + lane * 2) = (bf16_t)f2bf(q * Dc); *(LAS bf16_t*)(wl + HK_OFF + t * 144 + lane * 2) = (bf16_t)ktb; }
        }
        __builtin_amdgcn_sched_barrier(0);
    }
#pragma unroll
    for (int c = 0; c < 4; ++c) { u32x4 w;
#pragma unroll
        for (int i = 0; i < 4; ++i) { const unsigned p = ktp[4 * c + i]; w[i] = pk2(__uint_as_float(p << 16) * Dc, __uint_as_float(p & 0xffff0000u) * Dc); }
        *(LAS u32x4*)(wl + HKH_OFF + lane * 80 + c * 16) = w; }
    *(LAS float*)(wl + HDEC_OFF + lane * 4) = Dc;
#pragma unroll
    for (int c = 0; c < 4; ++c) *(LAS u32x4*)(wl + HVT_OFF + lane * 80 + c * 16) = (u32x4){vp[4 * c], vp[4 * c + 1], vp[4 * c + 2], vp[4 * c + 3]};
    return Dc;
}
__device__ __forceinline__ void hg_update(LAS unsigned char* wl, f32x16 (&S)[2][2], int n, int h) {
#pragma unroll
    for (int kt = 0; kt < 2; ++kt) {
        f32x4 d4[4];
#pragma unroll
        for (int g = 0; g < 4; ++g) d4[g] = *(const LAS f32x4*)(wl + HDEC_OFF + (32 * kt + 8 * g + 4 * h) * 4);
        bf16x8 ka[2];
#pragma unroll
        for (int st = 0; st < 2; ++st) ka[st] = *(const LAS bf16x8*)(wl + HKH_OFF + (32 * kt + n) * 80 + (16 * st + 8 * h) * 2);
#pragma unroll
        for (int ct = 0; ct < 2; ++ct) {
#pragma unroll
            for (int g = 0; g < 4; ++g)
#pragma unroll
                for (int i = 0; i < 4; ++i) S[kt][ct][4 * g + i] *= d4[g][i];
#pragma unroll
            for (int st = 0; st < 2; ++st) { const bf16x8 vb = *(const LAS bf16x8*)(wl + HVT_OFF + (32 * ct + n) * 80 + (16 * st + 8 * h) * 2);
                S[kt][ct] = MFMA32(ka[st], vb, S[kt][ct]); }
        }
    }
}
template <int DIR>
__device__ __forceinline__ float hg_out(LAS unsigned char* wl, const f32x16 (&S)[2][2], int n, int h, GAS bf16_t* odst) {
    f32x16 at;
#pragma unroll
    for (int r = 0; r < 16; ++r) at[r] = 0.f;
#pragma unroll
    for (int ks = 0; ks < 4; ++ks) { const bf16x8 a = *(const LAS bf16x8*)(wl + HK_OFF + n * 144 + ks * 32 + h * 16), b = *(const LAS bf16x8*)(wl + HQ_OFF + n * 144 + ks * 32 + h * 16);
        at = MFMA32(a, b, at); }
#pragma unroll
    for (int r = 0; r < 16; ++r) { const int sidx = (r & 3) + 8 * (r >> 2) + 4 * h; const bool keep = DIR ? (sidx >= n) : (sidx <= n); at[r] = keep ? at[r] : 0.f; }
    const bf16x8 xs0 = pack8(at, 0), xs1 = pack8(at, 8);
    float ss = 0.f;
#pragma unroll
    for (int vt = 0; vt < 2; ++vt) {
        f32x16 Ov;
#pragma unroll
        for (int r = 0; r < 16; ++r) Ov[r] = 0.f;
#pragma unroll
        for (int st = 0; st < 2; ++st) { const LAS unsigned char* vp = wl + HVT_OFF + (32 * vt + n) * 80 + (16 * st + 4 * h) * 2;
            const u32x2 lo = *(const LAS u32x2*)vp, hi2 = *(const LAS u32x2*)(vp + 16);
            Ov = MFMA32(__builtin_bit_cast(bf16x8, (u32x4){lo.x, lo.y, hi2.x, hi2.y}), st ? xs1 : xs0, Ov); }
#pragma unroll
        for (int kt = 0; kt < 2; ++kt)
#pragma unroll
            for (int st = 0; st < 2; ++st) { const LAS unsigned char* qp = wl + HQ_OFF + n * 144 + (32 * kt + 16 * st + 4 * h) * 2;
                const u32x2 lo = *(const LAS u32x2*)qp, hi2 = *(const LAS u32x2*)(qp + 16);
                Ov = MFMA32(pack8(S[kt][vt], 8 * st), __builtin_bit_cast(bf16x8, (u32x4){lo.x, lo.y, hi2.x, hi2.y}), Ov); }
#pragma unroll
        for (int g = 0; g < 4; ++g) {
            float o[4] = {Ov[4 * g], Ov[4 * g + 1], Ov[4 * g + 2], Ov[4 * g + 3]};
            if (DIR == 1) { const u32x2 pw = *(const GAS u32x2*)(odst + 32 * vt + 8 * g);
                o[0] += __uint_as_float(pw.x << 16); o[1] += __uint_as_float(pw.x & 0xffff0000u); o[2] += __uint_as_float(pw.y << 16); o[3] += __uint_as_float(pw.y & 0xffff0000u);
                ss += (o[0] * o[0] + o[1] * o[1]) + (o[2] * o[2] + o[3] * o[3]); }
            u32x2 w; w.x = pk2(o[0], o[1]); w.y = pk2(o[2], o[3]); *(GAS u32x2*)(odst + 32 * vt + 8 * g) = w; }
        __builtin_amdgcn_sched_barrier(0);
    }
    return ss;
}
__device__ __forceinline__ size_t hg_row0(int b, int cidx) { return cidx < 4 ? (size_t)(ML + b * LCTX + cidx * 64) : (size_t)(b * SEQ + (cidx - 4) * 64); }
template <int DIR>
__device__ __forceinline__ void hgrn_passA_dir(int bh, int cidx, int l, GAS unsigned char* ws, LAS unsigned char* wl, int lane) {
    const int b = bh >> 2, hd = bh & 3, n = lane & 31, h = lane >> 5;
    const GAS bf16_t* Pp = (const GAS bf16_t*)(ws + WS_PP); GAS float* SB = (GAS float*)(ws + WS_H); GAS float* AV = (GAS float*)(ws + WS_AV);
    const float lb = hgrn_lb((const GAS float*)(ws + WS_SM) + SM_LB, l, DIR, hd * 64 + lane);
    const size_t row0 = hg_row0(b, cidx);
    f32x16 S[2][2];
#pragma unroll
    for (int i = 0; i < 4; ++i)
#pragma unroll
        for (int r = 0; r < 16; ++r) S[i >> 1][i & 1][r] = 0.f;
    float dtot = 1.f;
#pragma unroll
    for (int si = 0; si < 2; ++si) {
        const int sub = DIR ? 1 - si : si;
        dtot *= hg_prep<DIR, false>(wl, Pp, row0 + 32 * sub, hd, lb, lane);
        LDS_WAIT();
        hg_update(wl, S, n, h);
        LDS_WAIT();
    }
    const size_t sidx = (size_t)(bh * 2 + DIR) * NCH + cidx;
    GAS bf16_t* sb = (GAS bf16_t*)SB + sidx * 4096 + (size_t)n * 64 + 4 * h;
#pragma unroll
    for (int kt = 0; kt < 2; ++kt)
#pragma unroll
        for (int ct = 0; ct < 2; ++ct)
#pragma unroll
            for (int g = 0; g < 4; ++g) { u32x2 w; w.x = pk2(S[kt][ct][4 * g], S[kt][ct][4 * g + 1]); w.y = pk2(S[kt][ct][4 * g + 2], S[kt][ct][4 * g + 3]);
                *(GAS u32x2*)(sb + (32 * ct) * 64 + 32 * kt + 8 * g) = w; }
    AV[sidx * 64 + lane] = dtot;
}
template <int DIR>
__device__ __forceinline__ void hgrn_passC_dir(int bh, int cidx, int l, GAS unsigned char* ws, LAS unsigned char* wl, int lane) {
    const int b = bh >> 2, hd = bh & 3, n = lane & 31, h = lane >> 5;
    const GAS bf16_t* Pp = (const GAS bf16_t*)(ws + WS_PP); const GAS float* SB = (const GAS float*)(ws + WS_H); const GAS float* AV = (const GAS float*)(ws + WS_AV);
    GAS bf16_t* MO = (GAS bf16_t*)(ws + WS_MO); const GAS float* sm = (const GAS float*)(ws + WS_SM);
    const float lb = hgrn_lb(sm + SM_LB, l, DIR, hd * 64 + lane);
    const size_t row0 = hg_row0(b, cidx);
    f32x16 S[2][2];
#pragma unroll
    for (int i = 0; i < 4; ++i)
#pragma unroll
        for (int r = 0; r < 16; ++r) S[i >> 1][i & 1][r] = 0.f;
    {
        const size_t sidx = (size_t)(bh * 2 + DIR) * NCH + cidx;
        const GAS bf16_t* sb = (const GAS bf16_t*)SB + sidx * 4096 + (size_t)n * 64 + 4 * h; asm volatile("" : "+v"(sb)); ASSUME_GLOBAL(sb);
#pragma unroll
        for (int kt = 0; kt < 2; ++kt)
#pragma unroll
            for (int ct = 0; ct < 2; ++ct)
#pragma unroll
                for (int g = 0; g < 4; ++g) { const u32x2 w = *(const GAS u32x2*)(sb + (32 * ct) * 64 + 32 * kt + 8 * g);
                    S[kt][ct][4 * g] = __uint_as_float(w.x << 16); S[kt][ct][4 * g + 1] = __uint_as_float(w.x & 0xffff0000u); S[kt][ct][4 * g + 2] = __uint_as_float(w.y << 16); S[kt][ct][4 * g + 3] = __uint_as_float(w.y & 0xffff0000u); }
    }
#pragma unroll
    for (int si = 0; si < 2; ++si) {
        const int sub = DIR ? 1 - si : si;
        int lane_o = lane; asm volatile("" : "+v"(lane_o));
        const int lane = lane_o, n = lane & 31, h = lane >> 5;
        GAS unsigned char* ws_o = ws; asm volatile("" : "+s"(ws_o)); ASSUME_GLOBAL(ws_o);
        const GAS bf16_t* Pp = (const GAS bf16_t*)(ws_o + WS_PP); GAS bf16_t* MO = (GAS bf16_t*)(ws_o + WS_MO); const GAS float* sm = (const GAS float*)(ws_o + WS_SM);
        const size_t row0s = hg_row0(b, cidx) + 32 * sub;
        __builtin_amdgcn_sched_barrier(0);
        hg_prep<DIR, true>(wl, Pp, row0s, hd, lb, lane);
        LDS_WAIT();
        __builtin_amdgcn_sched_barrier(0);
        GAS bf16_t* odst = MO + (row0s + n) * D + MO_HG + hd * 64 + 4 * h;
        float ss = hg_out<DIR>(wl, S, n, h, odst);
        __builtin_amdgcn_sched_barrier(0);
        hg_update(wl, S, n, h);
        LDS_WAIT();
        __builtin_amdgcn_sched_barrier(0);
        if (DIR == 1) {
            const size_t row = row0s + n;
            ss = half_sum(ss);
            const float rstd = __builtin_amdgcn_rsqf(ss * (1.f / 64.f) + EPS);
#pragma unroll
            for (int vt = 0; vt < 2; ++vt)
#pragma unroll
                for (int g = 0; g < 4; ++g) { const int cb = 32 * vt + 8 * g + 4 * h;
                    const u32x2 pw = *(const GAS u32x2*)(odst + 32 * vt + 8 * g);
                    const u32x2 gw = *(const GAS u32x2*)(Pp + row * NP + PC_HG + hd * 64 + cb);
                    const f32x4 nw4 = *(const GAS f32x4*)(sm + SM_HGNW + l * 64 + cb);
                    const float g0 = __uint_as_float(gw.x << 16), g1 = __uint_as_float(gw.x & 0xffff0000u), g2 = __uint_as_float(gw.y << 16), g3 = __uint_as_float(gw.y & 0xffff0000u);
                    u32x2 w; w.x = pk2(__uint_as_float(pw.x << 16) * rstd * nw4[0] * (g0 * sigm(g0)), __uint_as_float(pw.x & 0xffff0000u) * rstd * nw4[1] * (g1 * sigm(g1)));
                    w.y = pk2(__uint_as_float(pw.y << 16) * rstd * nw4[2] * (g2 * sigm(g2)), __uint_as_float(pw.y & 0xffff0000u) * rstd * nw4[3] * (g3 * sigm(g3)));
                    *(GAS u32x2*)(odst + 32 * vt + 8 * g) = w;
                    if (g == 3) asm volatile("" ::: "memory"); }
        }
    }
}
__device__ __forceinline__ void hgrn_passA(int task, int l, GAS unsigned char* ws, LAS unsigned char* lds) {
    const int tid = tid_opq(), lane = tid & 63, wid = tid >> 6;
    LAS unsigned char* wl = lds + wid * HG_WL;
    const int dir = task & 1, t2 = task >> 1, cidx = t2 % NCH, bh = t2 / NCH;
    if (dir) hgrn_passA_dir<1>(bh, cidx, l, ws, wl, lane); else hgrn_passA_dir<0>(bh, cidx, l, ws, wl, lane);
}
__device__ __forceinline__ void hgrn_passC(int task, int l, GAS unsigned char* ws, LAS unsigned char* lds) {
    const int tid = tid_opq(), lane = tid & 63, wid = tid >> 6;
    LAS unsigned char* wl = lds + wid * HG_WL;
    const int cidx = task % NCH, bh = task / NCH;
    if (l == DEPTH - 1 && cidx < 4) return;
#ifndef HGC_MASK
#define HGC_MASK 3
#endif
    if (HGC_MASK & 1) hgrn_passC_dir<0>(bh, cidx, l, ws, wl, lane);
    if (HGC_MASK & 2) hgrn_passC_dir<1>(bh, cidx, l, ws, wl, lane);
}

__device__ __forceinline__ void prep_run(int m0, int cnt, int l, GAS unsigned char* ws, bool dry) {
    const int lane = tid_opq() & 63, li = lane & 15, hq = lane >> 4;
    GAS bf16_t* Pp = (GAS bf16_t*)(ws + WS_PP); GAS bf16_t* MO = (GAS bf16_t*)(ws + WS_MO); const GAS float* sm = (const GAS float*)(ws + WS_SM);
    const bool lowhalf = (li & 4) == 0;
    int cbv[3]; bool actv[3];
#pragma unroll
    for (int ps = 0; ps < 3; ++ps) { const int hh = ps * 4 + hq; actv[ps] = hh < 10; const int hc = actv[ps] ? hh : 9; cbv[ps] = (hc < 8 ? PC_Q + hc * 64 : PC_K + (hc - 8) * 64) + 4 * li; }
    f32x4 w4[3];
#pragma unroll
    for (int ps = 0; ps < 3; ++ps) w4[ps] = *(const GAS f32x4*)(sm + ((ps * 4 + hq) < 8 ? SM_QNW : SM_KNW) + l * 64 + 4 * li);
    u32x2 rawn[3];
#pragma unroll
    for (int ps = 0; ps < 3; ++ps) rawn[ps] = *(const GAS u32x2*)(Pp + (size_t)m0 * NP + cbv[ps]);
    const int w2 = 1 << (lane >> 4);
    float s0 = 0.f, s1 = 0.f, s2 = 0.f, s3 = 0.f; int lo = 0, hi = 0;
#pragma unroll 1
    for (int i = 0; i < cnt; ++i) {
        const int m = m0 + i;
        const bool isc = m >= ML; const int t = isc ? ((m - ML) & 255) : (m & 2047);
        GAS bf16_t* pr = Pp + (size_t)m * NP;
        u32x2 raw[3];
#pragma unroll
        for (int ps = 0; ps < 3; ++ps) raw[ps] = rawn[ps];
        if (i + 1 < cnt) {
#pragma unroll
            for (int ps = 0; ps < 3; ++ps) rawn[ps] = *(const GAS u32x2*)(pr + NP + cbv[ps]);
        }
        const int Lseg = isc ? LCTX : SEQ;
        const int nlo = t - w2 < 0 ? 0 : t - w2, nhi = t + w2 > Lseg ? Lseg : t + w2;
        const GAS bf16_t* seg = Pp + (size_t)(m - t) * NP + 4 * lane;
        const u32x2 uself = *(const GAS u32x2*)(seg + (size_t)t * NP);
        if (i == 0 || t == 0) {
            s0 = 0.f; s1 = 0.f; s2 = 0.f; s3 = 0.f;
#pragma unroll 4
            for (int tt = nlo; tt < nhi; ++tt) { const u32x2 u = *(const GAS u32x2*)(seg + (size_t)tt * NP);
                s0 += __uint_as_float(u.x << 16); s1 += __uint_as_float(u.x & 0xffff0000u); s2 += __uint_as_float(u.y << 16); s3 += __uint_as_float(u.y & 0xffff0000u); }
        } else {
            const bool add = nhi > hi, rem = nlo > lo;
            u32x2 ua = {0u, 0u}, ur = {0u, 0u};
            if (add) ua = *(const GAS u32x2*)(seg + (size_t)(nhi - 1) * NP);
            if (rem) ur = *(const GAS u32x2*)(seg + (size_t)lo * NP);
            s0 += __uint_as_float(ua.x << 16) - __uint_as_float(ur.x << 16); s1 += __uint_as_float(ua.x & 0xffff0000u) - __uint_as_float(ur.x & 0xffff0000u);
            s2 += __uint_as_float(ua.y << 16) - __uint_as_float(ur.y << 16); s3 += __uint_as_float(ua.y & 0xffff0000u) - __uint_as_float(ur.y & 0xffff0000u);
        }
        lo = nlo; hi = nhi;
        float cs[4], sn[4];
        const float pos = (float)((li < 8) ? (t >> 6) : (t & 63));
#pragma unroll
        for (int j = 0; j < 4; ++j) { const int i16 = (4 * li + j) & 15; const float ang = pos * __builtin_amdgcn_exp2f(-(float)i16 * (13.287712379549449f / 16.f)); cs[j] = __cosf(ang); sn[j] = __sinf(ang); }
#pragma unroll
        for (int ps = 0; ps < 3; ++ps) {
            const bool isq = (ps * 4 + hq) < 8;
            float x[4] = {__uint_as_float(raw[ps].x << 16), __uint_as_float(raw[ps].x & 0xffff0000u), __uint_as_float(raw[ps].y << 16), __uint_as_float(raw[ps].y & 0xffff0000u)};
            const float ss = row16_sum((x[0] * x[0] + x[1] * x[1]) + (x[2] * x[2] + x[3] * x[3]));
            const float r = __builtin_amdgcn_rsqf(ss * (1.f / 64.f) + EPS);
            float y[4];
#pragma unroll
            for (int j = 0; j < 4; ++j) { y[j] = x[j] * r * w4[ps][j]; const float p = __int_as_float(__builtin_amdgcn_ds_swizzle(__float_as_int(y[j]), 0x101F));
                if (!isc) y[j] = lowhalf ? (y[j] * cs[j] - p * sn[j]) : (y[j] * cs[j] + p * sn[j]); if (isq) y[j] *= 0.125f * 1.4426950408889634f; }
            u32x2 o; o.x = pk2(y[0], y[1]); o.y = pk2(y[2], y[3]);
            if (actv[ps]) *(GAS u32x2*)((dry ? (GAS bf16_t*)(ws + WS_MODP) + (size_t)(m & 1023) * NP : pr) + cbv[ps]) = o;
        }
        const float inv = __builtin_amdgcn_rcpf((float)(nhi - nlo));
        u32x2 o; o.x = pk2(s0 * inv - __uint_as_float(uself.x << 16), s1 * inv - __uint_as_float(uself.x & 0xffff0000u));
        o.y = pk2(s2 * inv - __uint_as_float(uself.y << 16), s3 * inv - __uint_as_float(uself.y & 0xffff0000u));
        *(GAS u32x2*)(MO + (size_t)m * D + MO_POOL + 4 * lane) = o;
    }
}
__device__ __forceinline__ void vt_task(int task, GAS unsigned char* ws) {
    const int lane = tid_opq() & 63;
    const GAS bf16_t* Pp = (const GAS bf16_t*)(ws + WS_PP); GAS bf16_t* Vt = (GAS bf16_t*)(ws + WS_VT);
    const int j = task % 36, bk = task / 36, b = bk >> 1, kvh = bk & 1;
    const size_t row0 = j < 32 ? (size_t)(b * SEQ + j * 64) : (size_t)(ML + b * LCTX + (j - 32) * 64);
    const GAS bf16_t* pv = Pp + row0 * NP + PC_V + kvh * 64 + lane;
    GAS bf16_t* dst = Vt + ((size_t)bk * 64 + lane) * SKV + j * 64;
#pragma unroll
    for (int c = 0; c < 8; ++c) { u32x4 w;
        w.x = (unsigned)pv[(size_t)(8 * c) * NP] | ((unsigned)pv[(size_t)(8 * c + 1) * NP] << 16); w.y = (unsigned)pv[(size_t)(8 * c + 2) * NP] | ((unsigned)pv[(size_t)(8 * c + 3) * NP] << 16);
        w.z = (unsigned)pv[(size_t)(8 * c + 4) * NP] | ((unsigned)pv[(size_t)(8 * c + 5) * NP] << 16); w.w = (unsigned)pv[(size_t)(8 * c + 6) * NP] | ((unsigned)pv[(size_t)(8 * c + 7) * NP] << 16);
        *(GAS u32x4*)(dst + 8 * c) = w; }
}

constexpr int KV_BUF = 9216 + 8704;
__device__ __forceinline__ void attn_unit(LAS unsigned char* lds, const GAS bf16_t* Pp, const GAS bf16_t* Vt, GAS bf16_t* MO, int b, int kvh, int rowbase, int wstride, int offB, int headA, int headB, int key0, int ntiles) {
    const int tid = tid_opq(), lane = tid & 63, wid = tid >> 6, r32 = lane & 31, hi = lane >> 5;
    size_t qrow[2]; int hd[2];
    qrow[0] = (size_t)(rowbase + wid * wstride + r32); qrow[1] = qrow[0] + offB; hd[0] = headA; hd[1] = headB;
    bf16x8 qr[2][4];
#pragma unroll
    for (int qb = 0; qb < 2; ++qb)
#pragma unroll
        for (int d0 = 0; d0 < 4; ++d0) qr[qb][d0] = *(const GAS bf16x8*)(Pp + qrow[qb] * NP + PC_Q + hd[qb] * 64 + d0 * 16 + hi * 8);
    const int lk = tid >> 3, lc = tid & 7;
    const GAS bf16_t* vsrc = Vt + ((size_t)(b * 2 + kvh) * 64 + lk) * SKV + lc * 8;
    const GAS bf16_t* kcol = Pp + PC_K + kvh * 64 + lc * 8;
    u32x4 kreg, vreg;
    auto load_tile = [&](int j) {
        const int s = key0 + j * 64 + lk;
        const size_t kr = s < SEQ ? (size_t)(b * SEQ + s) : (size_t)(ML + b * LCTX + (s - SEQ));
        kreg = *(const GAS u32x4*)(kcol + kr * NP);
        vreg = *(const GAS u32x4*)(vsrc + key0 + j * 64);
    };
    auto store_tile = [&](int buf) {
        LAS unsigned char* kb = lds + buf * KV_BUF;
        *(LAS u32x4*)(kb + lk * 144 + lc * 16) = kreg;
        LAS unsigned char* vb = kb + 9216 + lk * 136 + lc * 16;
        *(LAS u32x2*)(vb) = (u32x2){vreg.x, vreg.y}; *(LAS u32x2*)(vb + 8) = (u32x2){vreg.z, vreg.w};
    };
    load_tile(0); store_tile(0);
    __syncthreads();
    f32x16 o[2][2], negm[2];
#pragma unroll
    for (int qb = 0; qb < 2; ++qb)
#pragma unroll
        for (int r = 0; r < 16; ++r) { o[qb][0][r] = 0.f; o[qb][1][r] = 0.f; negm[qb][r] = 0.f; }
    float mrun[2] = {0.f, 0.f}, lrun[2] = {0.f, 0.f};
    for (int j = 0; j < ntiles; ++j) {
        const int buf = j & 1;
        if (j + 1 < ntiles) load_tile(j + 1);
        const LAS unsigned char* kb = lds + buf * KV_BUF + r32 * 144 + hi * 16;
        f32x16 p[2][2];
#pragma unroll
        for (int d0 = 0; d0 < 4; ++d0) {
            const bf16x8 a0 = *(const LAS bf16x8*)(kb + d0 * 32), a1 = *(const LAS bf16x8*)(kb + 32 * 144 + d0 * 32);
#pragma unroll
            for (int qb = 0; qb < 2; ++qb) {
                p[qb][0] = __builtin_amdgcn_mfma_f32_32x32x16_bf16(a0, qr[qb][d0], d0 == 0 ? negm[qb] : p[qb][0], 0, 0, 0);
                p[qb][1] = __builtin_amdgcn_mfma_f32_32x32x16_bf16(a1, qr[qb][d0], d0 == 0 ? negm[qb] : p[qb][1], 0, 0, 0);
            }
        }
#pragma unroll
        for (int qb = 0; qb < 2; ++qb) {
            f32x16& p0 = p[qb][0]; f32x16& p1 = p[qb][1];
            float ma = __builtin_fmaxf(__builtin_fmaxf(p0[0], p0[1]), p1[0]), mb = __builtin_fmaxf(__builtin_fmaxf(p0[2], p0[3]), p1[1]);
            ma = __builtin_fmaxf(__builtin_fmaxf(ma, p1[2]), p1[3]);
#pragma unroll
            for (int r = 4; r < 16; r += 4) { ma = __builtin_fmaxf(__builtin_fmaxf(ma, p0[r]), p0[r + 1]); mb = __builtin_fmaxf(__builtin_fmaxf(mb, p0[r + 2]), p0[r + 3]);
                ma = __builtin_fmaxf(__builtin_fmaxf(ma, p1[r]), p1[r + 1]); mb = __builtin_fmaxf(__builtin_fmaxf(mb, p1[r + 2]), p1[r + 3]); }
            const float mx = half_max(__builtin_fmaxf(ma, mb));
            if (j == 0 || __any(mx > 8.0f)) {
                const float dl = j == 0 ? mx : __builtin_fmaxf(mx, 0.f);
                mrun[qb] += dl;
                const float alpha = __builtin_amdgcn_exp2f(-dl);
                lrun[qb] *= alpha;
#pragma unroll
                for (int r = 0; r < 16; ++r) { p0[r] -= dl; p1[r] -= dl; o[qb][0][r] *= alpha; o[qb][1][r] *= alpha; negm[qb][r] = -mrun[qb]; }
            }
            f32x2 ls2 = {0.f, 0.f};
#pragma unroll
            for (int r = 0; r < 16; r += 2) { p0[r] = __builtin_amdgcn_exp2f(p0[r]); p0[r + 1] = __builtin_amdgcn_exp2f(p0[r + 1]); p1[r] = __builtin_amdgcn_exp2f(p1[r]); p1[r + 1] = __builtin_amdgcn_exp2f(p1[r + 1]);
                ls2 += (f32x2){p0[r], p0[r + 1]}; ls2 += (f32x2){p1[r], p1[r + 1]}; }
            lrun[qb] += ls2.x + ls2.y;
        }
        const LAS unsigned char* vb = lds + buf * KV_BUF + 9216 + r32 * 136 + hi * 8;
#pragma unroll
        for (int j4 = 0; j4 < 4; ++j4) {
            bf16x8 pb[2];
#pragma unroll
            for (int qb = 0; qb < 2; ++qb) { const f32x16& ps = p[qb][j4 >> 1]; const int bs = 8 * (j4 & 1);
                u32x4 pw; pw.x = pk2(ps[bs], ps[bs + 1]); pw.y = pk2(ps[bs + 2], ps[bs + 3]); pw.z = pk2(ps[bs + 4], ps[bs + 5]); pw.w = pk2(ps[bs + 6], ps[bs + 7]);
                pb[qb] = __builtin_bit_cast(bf16x8, pw); }
            const u32x2 l0 = *(const LAS u32x2*)(vb + j4 * 32), h0 = *(const LAS u32x2*)(vb + j4 * 32 + 16);
            const u32x2 l1 = *(const LAS u32x2*)(vb + 32 * 136 + j4 * 32), h1 = *(const LAS u32x2*)(vb + 32 * 136 + j4 * 32 + 16);
            const bf16x8 va0 = __builtin_bit_cast(bf16x8, (u32x4){l0.x, l0.y, h0.x, h0.y});
            const bf16x8 va1 = __builtin_bit_cast(bf16x8, (u32x4){l1.x, l1.y, h1.x, h1.y});
#pragma unroll
            for (int qb = 0; qb < 2; ++qb) {
                o[qb][0] = __builtin_amdgcn_mfma_f32_32x32x16_bf16(va0, pb[qb], o[qb][0], 0, 0, 0);
                o[qb][1] = __builtin_amdgcn_mfma_f32_32x32x16_bf16(va1, pb[qb], o[qb][1], 0, 0, 0);
            }
        }
        if (j + 1 < ntiles) store_tile(buf ^ 1);
        __syncthreads();
    }
#pragma unroll
    for (int qb = 0; qb < 2; ++qb) {
        const float inv = __builtin_amdgcn_rcpf(half_sum(lrun[qb]));
        GAS bf16_t* op = MO + qrow[qb] * D + MO_ATT + hd[qb] * 64 + 4 * hi;
#pragma unroll
        for (int g = 0; g < 4; ++g) {
            u32x2 w0; w0.x = pk2(o[qb][0][4 * g] * inv, o[qb][0][4 * g + 1] * inv); w0.y = pk2(o[qb][0][4 * g + 2] * inv, o[qb][0][4 * g + 3] * inv);
            u32x2 w1; w1.x = pk2(o[qb][1][4 * g] * inv, o[qb][1][4 * g + 1] * inv); w1.y = pk2(o[qb][1][4 * g + 2] * inv, o[qb][1][4 * g + 3] * inv);
            *(GAS u32x2*)(op + 8 * g) = w0; *(GAS u32x2*)(op + 32 + 8 * g) = w1;
        }
    }
}

__device__ __forceinline__ void phase_scan(GAS unsigned char* ws, int G) {
    const int tid = tid_opq();
    GAS unsigned* SB = (GAS unsigned*)(ws + WS_H); const GAS float* AV = (const GAS float*)(ws + WS_AV);
    for (int e = blockIdx.x * NTHR + tid; e < 64 * 2048; e += G * NTHR) {
        const int seq = e >> 11, pr = e & 2047, k = (2 * pr) & 63, dir = seq & 1;
        GAS unsigned* sb = SB + (size_t)seq * NCH * 2048 + pr; const GAS float* av = AV + (size_t)seq * NCH * 64 + k;
        float S0 = 0.f, S1 = 0.f;
#pragma unroll 12
        for (int j = 0; j < NCH; ++j) {
            const int cj = dir == 0 ? j : (j < 4 ? 3 - j : 35 - (j - 4));
            const unsigned kv = sb[(size_t)cj * 2048]; const f32x2 a2 = *(const GAS f32x2*)(av + cj * 64);
            sb[(size_t)cj * 2048] = pk2(S0, S1);
            S0 = a2.x * S0 + __uint_as_float(kv << 16); S1 = a2.y * S1 + __uint_as_float(kv & 0xffff0000u);
        }
    }
}

#define XB_TMO      128
#define XB_XCNT(j)  (256  + 64 * (j))
#define XB_XSUB(j)  (1280 + 64 * (j))
#define XB_XGEN(j)  (2304 + 64 * (j))
#define XB_TOP      3328
#define XB_TOPGEN   3392
#define XCD_BAR_WORDS 3456
#define XB_SPIN_CAP (1u << 22)
__device__ __forceinline__ unsigned xb_ld(unsigned* p)              { return __hip_atomic_load(p, __ATOMIC_RELAXED, __HIP_MEMORY_SCOPE_AGENT); }
__device__ __forceinline__ unsigned xb_add(unsigned* p, unsigned v) { return __hip_atomic_fetch_add(p, v, __ATOMIC_RELAXED, __HIP_MEMORY_SCOPE_AGENT); }
__device__ __forceinline__ unsigned xb_xcc_id() { return (unsigned)__builtin_amdgcn_s_getreg((3 << 11) | 20) & 0xFu; }
#define XB_SPIN(cond, bar) do { unsigned _sp = 0; while (cond) { __builtin_amdgcn_s_sleep(1); \
    if ((++_sp & 255u) == 0u) { if (xb_ld(&(bar)[XB_TMO])) break; if (_sp > XB_SPIN_CAP) { atomicAdd(&(bar)[XB_TMO], 1u); break; } } } } while (0)
struct XcdBarrier { unsigned* bar; unsigned x; volatile LAS unsigned* st; };
__device__ __forceinline__ XcdBarrier xcd_barrier_post(unsigned* bar, volatile LAS unsigned* st, int tid) {
    XcdBarrier b; b.bar = bar; b.x = xb_xcc_id(); b.st = st;
    if (tid == 0) (void)xb_add(&bar[XB_XCNT(b.x)], 1u);
    return b;
}
__device__ __forceinline__ void xcd_barrier_complete(unsigned* bar, unsigned x, unsigned& nloc, unsigned& nx) {
    const unsigned G = gridDim.x * gridDim.y * gridDim.z;
    unsigned sum, cnt, mine, sp = 0u;
    for (;;) {
        sum = 0u; cnt = 0u; mine = 0u;
#pragma unroll
        for (unsigned j = 0; j < 16; ++j) { const unsigned c = xb_ld(&bar[XB_XCNT(j)]); sum += c; cnt += (c > 0u) ? 1u : 0u; mine = (j == x) ? c : mine; }
        if (sum == G) break;
        __builtin_amdgcn_s_sleep(1);
        if ((++sp & 255u) == 0u) { if (xb_ld(&bar[XB_TMO])) break; if (sp > XB_SPIN_CAP) { atomicAdd(&bar[XB_TMO], 1u); break; } }
    }
    nloc = mine > 0u ? mine : 1u; nx = cnt > 0u ? cnt : 1u;
}
__device__ __forceinline__ void xcd_barrier(const XcdBarrier& b, int tid) {
    asm volatile("s_waitcnt vmcnt(0)" ::: "memory");
    __syncthreads();
    if (tid == 0) {
        unsigned* bar = b.bar;
        __builtin_amdgcn_s_waitcnt(0);
        unsigned nloc = b.st[0], nx = b.st[1];
        if (nloc == 0u) { xcd_barrier_complete(bar, b.x, nloc, nx); b.st[0] = nloc; b.st[1] = nx; }
        const unsigned old = xb_add(&bar[XB_XSUB(b.x)], 1u);
        const unsigned gen = old / nloc;
        if (old + 1u == (gen + 1u) * nloc) {
            __builtin_amdgcn_fence(__ATOMIC_RELEASE, "agent");
            asm volatile("s_waitcnt vmcnt(0)" ::: "memory");
            const unsigned og = xb_add(&bar[XB_TOP], 1u);
            const unsigned tg = og / nx;
            if (og + 1u == (tg + 1u) * nx) xb_add(&bar[XB_TOPGEN], 1u);
            else XB_SPIN(xb_ld(&bar[XB_TOPGEN]) == tg, bar);
            __builtin_amdgcn_fence(__ATOMIC_ACQUIRE, "agent");
            xb_add(&bar[XB_XGEN(b.x)], 1u);
            asm volatile("s_waitcnt vmcnt(0)" ::: "memory");
        } else {
            XB_SPIN(xb_ld(&bar[XB_XGEN(b.x)]) == gen, bar);
            __builtin_amdgcn_fence(__ATOMIC_ACQUIRE, "agent");
            asm volatile("s_waitcnt vmcnt(0)" ::: "memory");
        }
    }
    __syncthreads();
}

__global__ void __launch_bounds__(NTHR, 2) mk_fwd(Args a) {
    extern __shared__ __attribute__((aligned(16))) unsigned char lds_raw[];
    LAS unsigned char* lds = (LAS unsigned char*)lds_raw;
    __shared__ int s_task;
    __shared__ unsigned xb_st[2];
    const int G = gridDim.x;
    if (threadIdx.x == 0) { xb_st[0] = 0u; xb_st[1] = 0u; }
    __syncthreads();
    const XcdBarrier xbar = xcd_barrier_post((unsigned*)(a.ws + WS_BAR), (volatile LAS unsigned*)xb_st, (int)threadIdx.x);
#define GRID_SYNC() xcd_barrier(xbar, tid_opq())

    for (int p = a.ph_lo; p < a.ph_hi; ++p) {
        if (ONLYP(100) && p == 0) phase_prologue(a, lds, G);
        else if (ONLYP(101) && p == 1) phase_modfinal(a, G);
        else {
            const int l = (p - 2) / 10, s = (p - 2) % 10;
            if (s == 7 || (s == 0 && l > 0)) continue;
            const bool last = (l == DEPTH - 1);
            const int Mpost = last ? ML : MA;
            for (int rep = 0; rep < REP_S[s]; ++rep) {
            if (rep > 0) GRID_SYNC();
            GAS unsigned char* ws = ((GAS unsigned char*)a.ws); asm volatile("" : "+s"(ws));
            GAS float* XL = ((GAS float*)a.out); asm volatile("" : "+s"(XL));
            ASSUME_GLOBAL(ws); ASSUME_GLOBAL(XL);
            GAS float* XC = (GAS float*)(ws + WS_XC);
            const GAS float* modf_l = (const GAS float*)(ws + WS_MODF) + (size_t)l * 9 * 6 * D;
            const GAS unsigned char* wl = ws + WS_W + l * W_LAYER;
            GAS float* dXL = rep ? (GAS float*)(ws + WS_PP) : XL; GAS float* dXC = rep ? (GAS float*)(ws + WS_PP) + (size_t)ML * D : XC;
            if (ONLYP(0) && s == 0) {
                phase_norm(l == 0 ? GIN(I_X) : XL, l == 0 ? GIN(I_CTX) : XC, (GAS bf16_t*)(ws + WS_H), modf_l, 1, 0, MA, G);
            } else if (ONLYP(1) && s == 1) {
                pg8::Gemm g{(const GAS bf16_t*)(ws + WS_H), (const GAS bf16_t*)(wl + WO_IN), MA, NIN, D, D, D}; pg8::StaticOrder S; S.init(MA, NIN, G, blockIdx.x, D / 64);
                pg8::EpiInProj E{(GAS bf16_t*)(ws + WS_PP), (GAS bf16_t*)(ws + WS_G)};
                pg8::gemm_phase<pg8::EpiInProj, true, pg8::StaticOrder>(lds, g, S, E);
            } else if (ONLYP(2) && s == 2) {
                const int wid = tid_opq() >> 6; const int gw = wid * G + blockIdx.x, NGW = G * 8;
                for (int t = gw; t < 8 * 4 * NCH * 2; t += NGW) hgrn_passA(t, l, ws, lds);
                if (NGW == 2048) {
                    if (gw < 256) prep_run(gw * 5, 5, l, ws, rep > 0);
                    else if (gw < 832) { vt_task(gw - 256, ws); prep_run(1280 + (gw - 256) * 8, 8, l, ws, rep > 0); }
                    else { const int w = gw - 832; if (w < 384) prep_run(5888 + w * 11, 11, l, ws, rep > 0); else prep_run(5888 + 384 * 11 + (w - 384) * 10, 10, l, ws, rep > 0); }
                } else {
                    for (int t = gw; t < 8 * 2 * 36; t += NGW) vt_task(t, ws);
                    for (int r = gw; r < MA / 9; r += NGW) prep_run(r * 9, 9, l, ws, rep > 0);
                }
            } else if (ONLYP(3) && s == 3) {
                phase_scan(ws, G);
            } else if (ONLYP(4) && s == 4) {
                const int NT = last ? 256 + 256 : 256 + 256 + 32;
                GAS int* ctr = (GAS int*)(ws + WS_CTL);
                const GAS bf16_t* Pp = (const GAS bf16_t*)(ws + WS_PP); const GAS bf16_t* Vt = (const GAS bf16_t*)(ws + WS_VT); GAS bf16_t* MO = (GAS bf16_t*)(ws + WS_MO);
                for (;;) {
                    const int tid = tid_opq(), wid = tid >> 6;
                    if (tid == 0) s_task = atomicAdd((int*)&ctr[64 * l + rep], 1);
                    __syncthreads();
                    const int t = s_task;
                    __syncthreads();
                    if (t >= NT) break;
                    if (t < 256) { const int first = (t * 9) >> 1, cnt = (((t + 1) * 9) >> 1) - first; if (wid < cnt) hgrn_passC(first + wid, l, ws, lds); }
                    else if (t < 512) { const int u = t - 256; const int hh = u & 3, qb = (u >> 2) & 3, bk = u >> 4; const int b = bk >> 1, kvh = bk & 1, head = kvh * 4 + hh;
                        attn_unit(lds, Pp, Vt, MO, b, kvh, b * SEQ + qb * 512, 64, 32, head, head, 0, SKV / 64); }
                    else { const int u = t - 512; const int b = u >> 2, hp = u & 3;
                        attn_unit(lds, Pp, Vt, MO, b, hp >> 1, ML + b * LCTX, 32, 0, 2 * hp, 2 * hp + 1, SEQ, LCTX / 64); }
                    __syncthreads();
                }
            } else if (ONLYP(5) && s == 5) {
                pg8::MergeOrder S; S.init(Mpost, G, blockIdx.x);
                pg8::Gemm g{(const GAS bf16_t*)(ws + WS_MO), (const GAS bf16_t*)(wl + WO_MG), Mpost, D, D, D, D};
                pg8::EpiMerge E{(const GAS bf16_t*)(ws + WS_G), (GAS bf16_t*)(ws + WS_H)};
                pg8::gemm_phase<pg8::EpiMerge, true, pg8::MergeOrder>(lds, g, S, E);
                if (!last && rep == 0 && (int)blockIdx.x >= 64) convert_layer(a, lds, l + 1, ((int)blockIdx.x - 64) * 8 + (tid_opq() >> 6), (G - 64) * 8, 0, 3);
            } else if (ONLYP(6) && s == 6) {
                pg8::Gemm g{(const GAS bf16_t*)(ws + WS_H), (const GAS bf16_t*)(wl + WO_O), Mpost, D, D, D, D}; pg8::StaticOrder S; S.init(Mpost, D, G, blockIdx.x, D / 64, true);
                pg8::EpiResidNorm E{l == 0 ? GIN(I_X) : XL, l == 0 ? GIN(I_CTX) : XC, XL, XC, modf_l + 2 * D, modf_l + 4 * D, modf_l + 3 * D, (GAS bf16_t*)(ws + WS_MO),
                    (GAS unsigned*)(ws + WS_NCNT) + (size_t)(l * 2 + 0) * 144 * 16, (GAS unsigned*)(ws + WS_XBUF), lds + pg8::STAGE_BYTES};
                pg8::gemm_phase<pg8::EpiResidNorm, true, pg8::StaticOrder>(lds, g, S, E);
                if (!last && rep == 0 && (int)blockIdx.x >= 64) convert_layer(a, lds, l + 1, ((int)blockIdx.x - 64) * 8 + (tid_opq() >> 6), (G - 64) * 8, 1, 3);
            } else if (ONLYP(7) && s == 7) {
                phase_norm(XL, XC, (GAS bf16_t*)(ws + WS_H), modf_l, 4, 3, Mpost, G);
            } else if (ONLYP(8) && s == 8) {
                pg8::Gemm g{(const GAS bf16_t*)(ws + WS_MO), (const GAS bf16_t*)(wl + WO_1), Mpost, NFF, D, D, D}; pg8::StaticOrder S; S.init(Mpost, NFF, G, blockIdx.x, D / 64);
                pg8::EpiSwiglu E{(GAS bf16_t*)(ws + WS_G)};
                pg8::gemm_phase<pg8::EpiSwiglu, true, pg8::StaticOrder>(lds, g, S, E);
            } else if (ONLYP(9)) {
                pg8::Gemm g{(const GAS bf16_t*)(ws + WS_G), (const GAS bf16_t*)(wl + WO_2), Mpost, D, DFF, DFF, DFF}; pg8::StaticOrder S; S.init(Mpost, D, G, blockIdx.x, DFF / 64, true);
                if (last) { pg8::EpiResid E{XL, XC, dXL, dXC, modf_l + 5 * D}; pg8::gemm_phase<pg8::EpiResid, true, pg8::StaticOrder>(lds, g, S, E); }
                else { const GAS float* modf_n = modf_l + (size_t)9 * 6 * D;
                    pg8::EpiResidNorm E{XL, XC, XL, XC, modf_l + 5 * D, modf_n + 1 * D, modf_n + 0 * D, (GAS bf16_t*)(ws + WS_H),
                        (GAS unsigned*)(ws + WS_NCNT) + (size_t)(l * 2 + 1) * 144 * 16, (GAS unsigned*)(ws + WS_XBUF), lds + pg8::STAGE_BYTES};
                    pg8::gemm_phase<pg8::EpiResidNorm, true, pg8::StaticOrder>(lds, g, S, E); }
                if (!last && rep == 0 && (int)blockIdx.x >= 64) convert_layer(a, lds, l + 1, ((int)blockIdx.x - 64) * 8 + (tid_opq() >> 6), (G - 64) * 8, 2, 3);
            }
            }
        }
        if (p + 1 < a.ph_hi) { if (a.ph_lo < 0) cg::this_grid().sync(); else GRID_SYNC(); }
    }
}

constexpr int N_PHASES = 2 + 10 * DEPTH;
extern "C" void kernel_launch(void* const* d_in, const int* in_sizes, int n_in, void* d_out, int out_size, void* d_ws, size_t ws_size, hipStream_t stream) {
    static int grid = 0;
    if (grid == 0) {
        if (n_in != 21 || out_size != ML * D || ws_size < WS_END) { fprintf(stderr, "kernel_launch: unexpected shapes (n_in %d out %d ws %zu need %zu)\n", n_in, out_size, ws_size, (size_t)WS_END); grid = -1; return; }
        int dev = 0, cus = 0, per_cu = 0;
        hipGetDevice(&dev); hipDeviceGetAttribute(&cus, hipDeviceAttributeMultiprocessorCount, dev);
        if (hipFuncSetAttribute((const void*)mk_fwd, hipFuncAttributeMaxDynamicSharedMemorySize, LDS_BYTES) != hipSuccess) { fprintf(stderr, "kernel_launch: hipFuncSetAttribute failed\n"); grid = -1; return; }
        if (hipOccupancyMaxActiveBlocksPerMultiprocessor(&per_cu, (const void*)mk_fwd, NTHR, LDS_BYTES) != hipSuccess || per_cu < 1) { fprintf(stderr, "kernel_launch: occupancy query says %d\n", per_cu); per_cu = 1; }
        (void)hipGetLastError();
        grid = cus * 1;
        fprintf(stderr, "kernel_launch: cus %d per_cu %d grid %d\n", cus, per_cu, grid);
    }
    if (grid < 0) return;
    hipMemsetAsync((char*)d_ws + WS_CTL, 0, 196608, stream);
    Args a{};
    for (int i = 0; i < 21; ++i) a.in[i] = (const float*)d_in[i];
    a.out = (float*)d_out; a.ws = (unsigned char*)d_ws;
#if MK_MULTI
    for (int p = 0; p < N_PHASES; ++p) { a.ph_lo = p; a.ph_hi = p + 1; hipLaunchKernelGGL(mk_fwd, dim3(grid), dim3(NTHR), LDS_BYTES, stream, a); }
#else
    a.ph_lo = 0; a.ph_hi = N_PHASES;
    void* args[] = {&a};
    hipError_t e = hipLaunchCooperativeKernel((const void*)mk_fwd, dim3(grid), dim3(NTHR), args, LDS_BYTES, stream);
    if (e != hipSuccess) fprintf(stderr, "kernel_launch: cooperative launch failed: %s (grid %d)\n", hipGetErrorString(e), grid);
#endif
}
```

```cpp
#include <hip/hip_runtime.h>
#include <hip/hip_cooperative_groups.h>
#include <cstdio>
#include <cstdint>
namespace cg = cooperative_groups;

#ifndef MK_MULTI
#define MK_MULTI 0
#endif

#ifndef ONLY
#define ONLY -1
#endif
#define ONLYP(k) (ONLY < 0 || ONLY == (k))
#define LAS __attribute__((address_space(3)))
#define GAS __attribute__((address_space(1)))
#define GIN(i) ((const GAS float*)a.in[i])
typedef unsigned short bf16_t;
typedef short bf16x8 __attribute__((ext_vector_type(8)));
typedef short s16x4 __attribute__((ext_vector_type(4)));
typedef float f32x2 __attribute__((ext_vector_type(2)));
typedef float f32x4 __attribute__((ext_vector_type(4)));
typedef float f32x16 __attribute__((ext_vector_type(16)));
typedef unsigned u32x2 __attribute__((ext_vector_type(2)));
typedef unsigned u32x4 __attribute__((ext_vector_type(4)));
typedef __bf16 bf16x2_t __attribute__((ext_vector_type(2)));

constexpr int D = 1024, NB = 8, SEQ = 2048, LCTX = 256, DEPTH = 4;
constexpr int ML = NB * SEQ, MC = NB * LCTX, MA = ML + MC;
constexpr int NIN = 5376, NP = 2304, NG = 3072, DFF = 2816, NFF = 5632;
constexpr int SKV = SEQ + LCTX;
constexpr float EPS = 1e-6f;
constexpr int PC_POOL = 0, PC_Q = 256, PC_K = 768, PC_V = 896, PC_HQ = 1024, PC_HI = 1280, PC_ZF = 1536, PC_ZB = 1792, PC_HG = 2048;
constexpr int MO_POOL = 0, MO_ATT = 256, MO_HG = 768;
constexpr int NCH = 36;

constexpr size_t MiB = 1u << 20;
constexpr size_t WS_CTL = 0;
constexpr size_t WS_NCNT = 65536;
constexpr size_t WS_XBUF = 262144;
constexpr size_t WS_BAR = 32768;
constexpr size_t WS_SM = 8192;
constexpr int SM_QNW = 0, SM_KNW = 256, SM_LB = 512, SM_HGNW = 2560, SM_N = 2816;
constexpr size_t WS_MODP = 1 * MiB;
constexpr size_t WS_MODF = 9 * MiB;
constexpr size_t WS_W = 10 * MiB;
constexpr size_t W_LAYER = 31 * MiB;
constexpr size_t WO_IN = 0, WO_MG = (size_t)NIN * D * 2, WO_O = WO_MG + (size_t)D * D * 2, WO_1 = WO_O + (size_t)D * D * 2, WO_2 = WO_1 + (size_t)NFF * D * 2;
static_assert(WO_2 + (size_t)D * DFF * 2 == W_LAYER, "weights per layer");
constexpr size_t WS_XC = WS_W + 4 * W_LAYER;
constexpr size_t WS_H = WS_XC + 8 * MiB;
constexpr size_t WS_PP = WS_H + 36 * MiB;
constexpr size_t WS_G = WS_PP + 81 * MiB;
constexpr size_t WS_MO = WS_G + 108 * MiB;
constexpr size_t WS_VT = WS_MO + 36 * MiB;
constexpr size_t WS_AV = WS_VT + 5 * MiB;
constexpr size_t WS_END = WS_AV + 1 * MiB;
constexpr int LDS_BYTES = 157696;
constexpr int NTHR = 512;
#define REPS {1, 1, 1, 1, 1, 1, 1, 1, 1, 1}
__device__ constexpr int REP_S[10] = REPS;

__device__ __forceinline__ float bf2f(bf16_t h) { return __uint_as_float((unsigned)h << 16); }
__device__ __forceinline__ unsigned f2bf(float f) { unsigned u = __float_as_uint(f); return (u + 0x7fffu + ((u >> 16) & 1u)) >> 16; }
__device__ __forceinline__ unsigned pk2(float lo, float hi) { f32x2 v = {lo, hi}; bf16x2_t b = __builtin_convertvector(v, bf16x2_t); return __builtin_bit_cast(unsigned, b); }
__device__ __forceinline__ float row16_sum(float v) {
    int x = __float_as_int(v);
    v += __int_as_float(__builtin_amdgcn_update_dpp(0, x, 0xB1, 0xF, 0xF, true)); x = __float_as_int(v);
    v += __int_as_float(__builtin_amdgcn_update_dpp(0, x, 0x4E, 0xF, 0xF, true)); x = __float_as_int(v);
    v += __int_as_float(__builtin_amdgcn_update_dpp(0, x, 0x124, 0xF, 0xF, true)); x = __float_as_int(v);
    v += __int_as_float(__builtin_amdgcn_update_dpp(0, x, 0x128, 0xF, 0xF, true));
    return v;
}
__device__ __forceinline__ float wave_sum(float v) {
    v = row16_sum(v);
    const int x = __float_as_int(v);
    return (__int_as_float(__builtin_amdgcn_readlane(x, 0)) + __int_as_float(__builtin_amdgcn_readlane(x, 16))) + (__int_as_float(__builtin_amdgcn_readlane(x, 32)) + __int_as_float(__builtin_amdgcn_readlane(x, 48)));
}
__device__ __forceinline__ float sigm(float x) { return __builtin_amdgcn_rcpf(1.f + __builtin_amdgcn_exp2f(x * -1.4426950408889634f)); }
__device__ __forceinline__ int tid_opq() { int t = threadIdx.x; asm volatile("" : "+v"(t)); return t; }
#if defined(__HIP_DEVICE_COMPILE__)
#define ASSUME_GLOBAL(p) __builtin_assume(!__builtin_amdgcn_is_shared((const void*)(p)) && !__builtin_amdgcn_is_private((const void*)(p)))
#else
#define ASSUME_GLOBAL(p) ((void)0)
#endif
#define LDS_WAIT() asm volatile("s_waitcnt lgkmcnt(0)" ::: "memory")

__device__ __forceinline__ float half_sum(float m);
namespace pg8 {
constexpr int BM = 256, BK = 64, HALF = 128, HTB = HALF * BK * 2, STAGE_BYTES = 8 * HTB, NXCD = 8, WGM = 8;
__host__ __device__ __forceinline__ int lds_byte(int r, int c) { const int st = (r >> 4) * 2 + (c >> 5), rr = r & 15, cc = c & 31, ob = rr * 64 + cc * 2; return st * 1024 + (ob ^ (((ob >> 9) & 1) << 5)); }
__host__ __device__ __forceinline__ void stage_rc(int b, int& R, int& C) { const int st = b / 1024, sb = b % 1024, swz = sb ^ (((sb >> 9) & 1) << 5); R = (st >> 1) * 16 + swz / 64; C = (st & 1) * 32 + (swz % 64) / 2; }
__host__ __device__ __forceinline__ int perm32(int rho) { const int n = rho >> 4, i = rho & 15; return 8 * (i >> 2) + 4 * n + (i & 3); }
struct Unit { int rt, pn, kt0, nkt, pass, half; };
struct Gemm { const GAS bf16_t* A; const GAS bf16_t* Bt; int M, N, K, lda, ldb; };
struct StaticOrder {
    int nM, nN, nwg, G, c, ntk, nhalf;
    __device__ void init(int M, int N, int G_, int c_, int ntk_, bool halfctx = false) {
        nN = N / BM; G = G_; c = c_; ntk = ntk_; nhalf = 0;
        if (halfctx && M > ML) { nM = ML / BM; nhalf = ((M - ML) / HALF) * nN; } else nM = M / BM;
        nwg = nM * nN;
    }
    __device__ void map(int wgid, Unit& u) const {
        u.half = 0;
        if (wgid >= nwg) { const int h = wgid - nwg; u.rt = ML / HALF + h / nN; u.pn = h % nN; u.half = 1; return; }
        { const int q = nwg / NXCD, r = nwg % NXCD, xcd = wgid % NXCD, off = wgid / NXCD; wgid = (xcd < r ? xcd * (q + 1) : r * (q + 1) + (xcd - r) * q) + off; }
        const int nig = WGM * nN, gid = wgid / nig, fm = gid * WGM, gsz = (nM - fm) < WGM ? (nM - fm) : WGM;
        u.rt = 2 * (fm + ((wgid % nig) % gsz)); u.pn = (wgid % nig) / gsz;
    }
    __device__ bool next(int i, Unit& u) const {
        const long L = (long)i * G + c; if (L >= nwg + nhalf) return false;
        map((int)L, u); u.kt0 = 0; u.nkt = ntk; u.pass = -1; return true;
    }
};
struct MergeOrder {
    StaticOrder so;
    __device__ void init(int M, int G_, int c_) { so.init(M, D, G_, c_, 16, true); }
    __device__ bool next(int i, Unit& u) const {
        const long L = (long)(i / 3) * so.G + so.c; if (L >= so.nwg + so.nhalf) return false;
        so.map((int)L, u); const int p = i % 3; u.pass = p; u.kt0 = p == 0 ? 0 : p == 1 ? 4 : 12; u.nkt = p == 1 ? 8 : 4; return true;
    }
};
template <class Epi, bool ALIGN_EPI, class Sched>
__device__ __forceinline__ void gemm_phase(LAS unsigned char* lds, const Gemm g, const Sched& S, const Epi& E) {
    const int tid = tid_opq(), wid = __builtin_amdgcn_readfirstlane(tid >> 6), lane = tid & 63, wr = wid >> 2, wc = wid & 3, fr = lane & 15, fq = lane >> 4;
    unsigned voffA[2], voffB[2];
#pragma unroll
    for (int i = 0; i < 2; ++i) { int R, C; stage_rc(tid * 16 + i * 8192, R, C); const int Rb = Epi::PERM ? ((R & ~31) + perm32(R & 31)) : R;
        voffA[i] = (unsigned)(R * g.lda + C) * 2u; voffB[i] = (unsigned)(Rb * g.ldb + C) * 2u; }
    const size_t kstep = (size_t)(BK * 2);
    const size_t hsA = (size_t)HALF * g.lda * 2, hsB = (size_t)HALF * g.ldb * 2;
    const size_t tsA = 2 * hsA, tsB = 2 * hsB;
    const unsigned ldsw = (unsigned)wid * 1024u;
    const int aoff = lds_byte(wr * 64 + fr, fq * 8), boff = lds_byte(wc * 32 + fr, fq * 8);
#define PG8_SA(b, h) (((b) * 2 + (h)) * HTB)
#define PG8_SB(b, h) ((4 + (b) * 2 + (h)) * HTB)
#define PG8_STAGE(bufoff, gbase, voff) do { _Pragma("unroll") for (int _i = 0; _i < 2; ++_i) \
        __builtin_amdgcn_global_load_lds((const GAS unsigned*)((const GAS char*)(gbase) + (voff)[_i]), (LAS unsigned*)(lds + (bufoff) + ldsw + _i * 8192), 16, 0, 0); } while (0)
#define PG8_LDA(dst, b, h) do { _Pragma("unroll") for (int m = 0; m < 4; ++m) _Pragma("unroll") for (int k = 0; k < 2; ++k) dst[m][k] = *(const LAS bf16x8*)(lds + PG8_SA(b, h) + aoff + m * 2048 + k * 1024); } while (0)
#define PG8_LDB(dst, b, h) do { _Pragma("unroll") for (int n = 0; n < 2; ++n) _Pragma("unroll") for (int k = 0; k < 2; ++k) dst[n][k] = *(const LAS bf16x8*)(lds + PG8_SB(b, h) + boff + n * 2048 + k * 1024); } while (0)
#define PG8_MMA(ai, bj, At, Bt) do { __builtin_amdgcn_s_setprio(1); _Pragma("unroll") for (int m = 0; m < 4; ++m) _Pragma("unroll") for (int n = 0; n < 2; ++n) _Pragma("unroll") for (int k = 0; k < 2; ++k) \
        acc[ai][bj][m][n] = __builtin_amdgcn_mfma_f32_16x16x32_bf16(Bt[n][k], At[m][k], acc[ai][bj][m][n], 0, 0, 0); __builtin_amdgcn_s_setprio(0); } while (0)
#define PG8_WAIT_V(n) asm volatile("s_waitcnt vmcnt(" #n ")" ::: "memory")
#define PG8_WAIT_L(n) asm volatile("s_waitcnt lgkmcnt(" #n ")" ::: "memory")
#define PG8_BAR __builtin_amdgcn_s_barrier()
#define PG8_SCHED __builtin_amdgcn_sched_barrier(0)
    Unit cur, nxt; int ui = 0;
    if (!S.next(0, cur)) return;
    f32x4 acc[2][2][4][2];
#pragma unroll
    for (int a = 0; a < 2; ++a)
#pragma unroll
        for (int b = 0; b < 2; ++b)
#pragma unroll
            for (int m = 0; m < 4; ++m)
#pragma unroll
                for (int n = 0; n < 2; ++n) acc[a][b][m][n] = (f32x4){0.f, 0.f, 0.f, 0.f};
    bf16x8 At[4][2], B0[2][2], B1[2][2];
    const GAS char* cA = (const GAS char*)g.A + (size_t)cur.rt * hsA + (size_t)cur.kt0 * kstep; const GAS char* cB = (const GAS char*)g.Bt + (size_t)cur.pn * tsB + (size_t)cur.kt0 * kstep;
    PG8_STAGE(PG8_SB(0, 0), cB, voffB); PG8_STAGE(PG8_SB(0, 1), cB + hsB, voffB); PG8_STAGE(PG8_SA(0, 0), cA, voffA); PG8_STAGE(PG8_SA(0, 1), cA + (cur.half ? 0 : hsA), voffA);
    if (wr == 1) PG8_BAR;
    PG8_WAIT_V(2); PG8_BAR;
    PG8_STAGE(PG8_SB(1, 0), cB + kstep, voffB); PG8_STAGE(PG8_SA(1, 0), cA + kstep, voffA); PG8_STAGE(PG8_SB(1, 1), cB + hsB + kstep, voffB);
    PG8_WAIT_V(6); PG8_BAR;
    for (;;) {
        const bool has_next = S.next(ui + 1, nxt);
        const GAS char* nA = has_next ? (const GAS char*)g.A + (size_t)nxt.rt * hsA + (size_t)nxt.kt0 * kstep : cA;
        const size_t hAc = cur.half ? 0 : hsA, hAn = has_next ? (nxt.half ? 0 : hsA) : hAc;
        const GAS char* nB = has_next ? (const GAS char*)g.Bt + (size_t)nxt.pn * tsB + (size_t)nxt.kt0 * kstep : cB;
        const int nt = cur.nkt;
        for (int t = 0; t < nt; t += 2) {
            const bool last = (t == nt - 2);
            const GAS char* a1 = cA + (size_t)(t + 1) * kstep;
            const GAS char* a2 = last ? nA : cA + (size_t)(t + 2) * kstep; const GAS char* b2 = last ? nB : cB + (size_t)(t + 2) * kstep;
            const GAS char* a3 = a2 + kstep; const GAS char* b3 = b2 + kstep;
            PG8_LDB(B0, 0, 0); PG8_LDB(B1, 0, 1); PG8_SCHED; PG8_LDA(At, 0, 0); PG8_STAGE(PG8_SA(1, 1), a1 + hAc, voffA);
            PG8_WAIT_V(8); PG8_WAIT_L(0); PG8_BAR; PG8_MMA(0, 0, At, B0); PG8_MMA(0, 1, At, B1); PG8_BAR; PG8_SCHED;
            PG8_LDA(At, 0, 1); PG8_STAGE(PG8_SB(0, 0), b2, voffB); PG8_STAGE(PG8_SB(0, 1), b2 + hsB, voffB); PG8_STAGE(PG8_SA(0, 0), a2, voffA);
            PG8_WAIT_V(8); PG8_WAIT_L(0); PG8_BAR; if (!cur.half) { PG8_MMA(1, 0, At, B0); PG8_MMA(1, 1, At, B1); } PG8_BAR; PG8_SCHED;
            PG8_LDB(B0, 1, 0); PG8_LDB(B1, 1, 1); PG8_SCHED; PG8_LDA(At, 1, 0); PG8_STAGE(PG8_SA(0, 1), a2 + (last ? hAn : hAc), voffA);
            PG8_WAIT_V(8); PG8_WAIT_L(0); PG8_BAR; PG8_MMA(0, 0, At, B0); PG8_MMA(0, 1, At, B1); PG8_BAR; PG8_SCHED;
            PG8_LDA(At, 1, 1); PG8_STAGE(PG8_SB(1, 0), b3, voffB); PG8_STAGE(PG8_SB(1, 1), b3 + hsB, voffB); PG8_STAGE(PG8_SA(1, 0), a3, voffA);
            PG8_WAIT_V(8); PG8_WAIT_L(0); PG8_BAR; if (!cur.half) { PG8_MMA(1, 0, At, B0); PG8_MMA(1, 1, At, B1); } PG8_BAR; PG8_SCHED;
        }
        if constexpr (ALIGN_EPI) { if (wr == 0) PG8_BAR; }
        E(acc, cur, wr, wc, fr, fq);
        if (!has_next) break;
        if (Epi::zero_after(cur))
#pragma unroll
        for (int a = 0; a < 2; ++a)
#pragma unroll
            for (int b = 0; b < 2; ++b)
#pragma unroll
                for (int m = 0; m < 4; ++m)
#pragma unroll
                    for (int n = 0; n < 2; ++n) acc[a][b][m][n] = (f32x4){0.f, 0.f, 0.f, 0.f};
        cur = nxt; cA = nA; cB = nB; ++ui;
        if constexpr (ALIGN_EPI) { if (wr == 1) PG8_BAR; }
    }
    PG8_WAIT_V(0);
    if constexpr (!ALIGN_EPI) { if (wr == 0) PG8_BAR; }
    PG8_BAR;
#undef PG8_SA
#undef PG8_SB
#undef PG8_STAGE
#undef PG8_LDA
#undef PG8_LDB
#undef PG8_MMA
#undef PG8_WAIT_V
#undef PG8_WAIT_L
#undef PG8_BAR
#undef PG8_SCHED
}

typedef f32x4 (&AccRef)[2][2][4][2];
struct EpiInProj {
    static constexpr bool PERM = true;
    __device__ static __forceinline__ bool zero_after(const Unit&) { return true; }
    GAS bf16_t* Pp; GAS bf16_t* G;
    __device__ __forceinline__ void operator()(AccRef acc, const Unit& u, int wr, int wc, int fr, int fq) const {
        const bool gate = u.pn >= 9;
        GAS bf16_t* base = gate ? G : Pp; const int ld = gate ? NG : NP; const int colt = gate ? (u.pn - 9) * BM : u.pn * BM;
        const int row0 = u.rt * HALF + wr * 64 + fr, col0 = colt + wc * 32 + 8 * fq;
#pragma unroll
        for (int ai = 0; ai < 2; ++ai)
#pragma unroll
            for (int m = 0; m < 4; ++m) { GAS bf16_t* rowp = base + (size_t)(row0 + ai * HALF + m * 16) * ld + col0;
#pragma unroll
                for (int bj = 0; bj < 2; ++bj) { f32x4 v0 = acc[ai][bj][m][0], v1 = acc[ai][bj][m][1];
                    if (gate) { v0 = (f32x4){sigm(v0[0]), sigm(v0[1]), sigm(v0[2]), sigm(v0[3])}; v1 = (f32x4){sigm(v1[0]), sigm(v1[1]), sigm(v1[2]), sigm(v1[3])}; }
                    u32x4 w; w.x = pk2(v0[0], v0[1]); w.y = pk2(v0[2], v0[3]); w.z = pk2(v1[0], v1[1]); w.w = pk2(v1[2], v1[3]);
                    *(GAS u32x4*)(rowp + bj * HALF) = w; } }
    }
};
struct EpiMerge {
    static constexpr bool PERM = true;
    const GAS bf16_t* G; GAS bf16_t* Yb;
    __device__ static __forceinline__ bool zero_after(const Unit& u) { return u.pass == 2; }
    __device__ __forceinline__ void operator()(AccRef acc, const Unit& u, int wr, int wc, int fr, int fq) const {
        const int row0 = u.rt * HALF + wr * 64 + fr, col0 = u.pn * BM + wc * 32 + 8 * fq, P = u.pass;
        const GAS bf16_t* gp = G + (size_t)row0 * NG + P * D + col0;
        u32x4 gb[2][2], hb[2][2];
#pragma unroll
        for (int bj = 0; bj < 2; ++bj) { gb[0][bj] = *(const GAS u32x4*)(gp + bj * HALF); if (P < 2) hb[0][bj] = *(const GAS u32x4*)(gp + D + bj * HALF); }
#pragma unroll
        for (int gi = 0; gi < 8; ++gi) {
            const int ai = gi >> 2, m = gi & 3, cb = gi & 1, nb = cb ^ 1;
            if (u.half && gi >= 4) break;
            if (gi < 7 && !(u.half && gi >= 3)) { const int ai2 = (gi + 1) >> 2, m2 = (gi + 1) & 3; const GAS bf16_t* q = gp + (size_t)(ai2 * HALF + m2 * 16) * NG;
#pragma unroll
                for (int bj = 0; bj < 2; ++bj) { gb[nb][bj] = *(const GAS u32x4*)(q + bj * HALF); if (P < 2) hb[nb][bj] = *(const GAS u32x4*)(q + D + bj * HALF); } }
            const size_t row = (size_t)(row0 + ai * HALF + m * 16);
#pragma unroll
            for (int bj = 0; bj < 2; ++bj) { const int col = col0 + bj * HALF;
                const u32x4 gw = gb[cb][bj];
                f32x4 g0 = {__uint_as_float(gw.x << 16), __uint_as_float(gw.x & 0xffff0000u), __uint_as_float(gw.y << 16), __uint_as_float(gw.y & 0xffff0000u)};
                f32x4 g1 = {__uint_as_float(gw.z << 16), __uint_as_float(gw.z & 0xffff0000u), __uint_as_float(gw.w << 16), __uint_as_float(gw.w & 0xffff0000u)};
                if (P < 2) {
                    const u32x4 hw = hb[cb][bj];
                    const f32x4 h0 = {__uint_as_float(hw.x << 16), __uint_as_float(hw.x & 0xffff0000u), __uint_as_float(hw.y << 16), __uint_as_float(hw.y & 0xffff0000u)};
                    const f32x4 h1 = {__uint_as_float(hw.z << 16), __uint_as_float(hw.z & 0xffff0000u), __uint_as_float(hw.w << 16), __uint_as_float(hw.w & 0xffff0000u)};
#pragma unroll
                    for (int i = 0; i < 4; ++i) { acc[ai][bj][m][0][i] *= g0[i] * __builtin_amdgcn_rcpf(fmaxf(h0[i], 1e-30f)); acc[ai][bj][m][1][i] *= g1[i] * __builtin_amdgcn_rcpf(fmaxf(h1[i], 1e-30f)); }
                } else {
                    const f32x4 y0 = g0 * acc[ai][bj][m][0], y1 = g1 * acc[ai][bj][m][1];
                    u32x4 w; w.x = pk2(y0[0], y0[1]); w.y = pk2(y0[2], y0[3]); w.z = pk2(y1[0], y1[1]); w.w = pk2(y1[2], y1[3]); *(GAS u32x4*)(Yb + row * D + col) = w;
                }
            }
            asm volatile("" ::: "memory");
        }
    }
};
struct EpiResid {
    static constexpr bool PERM = false;
    __device__ static __forceinline__ bool zero_after(const Unit&) { return true; }
    const GAS float* baseL; const GAS float* baseC; GAS float* outL; GAS float* outC; const GAS float* gv;
    __device__ __forceinline__ void operator()(AccRef acc, const Unit& u, int wr, int wc, int fr, int fq) const {
        const bool lat = u.rt < ML / HALF;
        const int bb = lat ? (u.rt >> 4) : 8;
        const int r0 = (lat ? u.rt * HALF : u.rt * HALF - ML) + wr * 64 + fr;
        const GAS float* base = lat ? baseL : baseC; GAS float* out = lat ? outL : outC;
        const int col0 = u.pn * BM + wc * 32 + 4 * fq;
        f32x4 g[2][2];
#pragma unroll
        for (int bj = 0; bj < 2; ++bj)
#pragma unroll
            for (int n = 0; n < 2; ++n) g[bj][n] = *(const GAS f32x4*)(gv + (size_t)bb * 6 * D + col0 + bj * HALF + n * 16);
        const GAS float* bp = base + (size_t)r0 * D + col0;
        f32x4 rb[2][2][2];
#pragma unroll
        for (int bj = 0; bj < 2; ++bj)
#pragma unroll
            for (int n = 0; n < 2; ++n) rb[0][bj][n] = *(const GAS f32x4*)(bp + bj * HALF + n * 16);
#pragma unroll
        for (int gi = 0; gi < 8; ++gi) {
            const int ai = gi >> 2, m = gi & 3, cb = gi & 1, nb = cb ^ 1;
            if (u.half && gi >= 4) break;
            if (gi < 7 && !(u.half && gi >= 3)) { const int ai2 = (gi + 1) >> 2, m2 = (gi + 1) & 3; const GAS float* q = bp + (size_t)(ai2 * HALF + m2 * 16) * D;
#pragma unroll
                for (int bj = 0; bj < 2; ++bj)
#pragma unroll
                    for (int n = 0; n < 2; ++n) rb[nb][bj][n] = *(const GAS f32x4*)(q + bj * HALF + n * 16); }
            const size_t off = (size_t)(r0 + ai * HALF + m * 16) * D + col0;
#pragma unroll
            for (int bj = 0; bj < 2; ++bj)
#pragma unroll
                for (int n = 0; n < 2; ++n) *(GAS f32x4*)(out + off + bj * HALF + n * 16) = rb[cb][bj][n] + g[bj][n] * acc[ai][bj][m][n];
            asm volatile("" ::: "memory");
        }
    }
};
struct EpiResidNorm {
    static constexpr bool PERM = false;
    __device__ static __forceinline__ bool zero_after(const Unit&) { return true; }
    const GAS float* baseL; const GAS float* baseC; GAS float* outL; GAS float* outC; const GAS float* gv;
    const GAS float* nsc; const GAS float* nsh; GAS bf16_t* Hn; GAS unsigned* cnt; GAS unsigned* xbuf; LAS unsigned char* xl;
    __device__ __forceinline__ void operator()(AccRef acc, const Unit& u, int wr, int wc, int fr, int fq) const {
        const bool lat = u.rt < ML / HALF;
        const int bb = lat ? (u.rt >> 4) : 8;
        const int r0 = (lat ? u.rt * HALF : u.rt * HALF - ML) + wr * 64 + fr;
        const GAS float* base = lat ? baseL : baseC; GAS float* out = lat ? outL : outC;
        const int col0 = u.pn * BM + wc * 32 + 4 * fq;
        const int ngr = u.half ? 4 : 8, nrows = u.half ? HALF : BM;
        LAS float* P = (LAS float*)xl; LAS float* S = (LAS float*)(xl + 4096);
        {
            f32x4 g[2][2];
#pragma unroll
            for (int bj = 0; bj < 2; ++bj)
#pragma unroll
                for (int n = 0; n < 2; ++n) g[bj][n] = *(const GAS f32x4*)(gv + (size_t)bb * 6 * D + col0 + bj * HALF + n * 16);
            const GAS float* bp = base + (size_t)r0 * D + col0;
            f32x4 rb[2][2][2];
#pragma unroll
            for (int bj = 0; bj < 2; ++bj)
#pragma unroll
                for (int n = 0; n < 2; ++n) rb[0][bj][n] = *(const GAS f32x4*)(bp + bj * HALF + n * 16);
#pragma unroll
            for (int gi = 0; gi < 8; ++gi) {
                const int ai = gi >> 2, m = gi & 3, cb = gi & 1, nb = cb ^ 1;
                if (gi >= ngr) break;
                if (gi + 1 < ngr) { const int ai2 = (gi + 1) >> 2, m2 = (gi + 1) & 3; const GAS float* q = bp + (size_t)(ai2 * HALF + m2 * 16) * D;
#pragma unroll
                    for (int bj = 0; bj < 2; ++bj)
#pragma unroll
                        for (int n = 0; n < 2; ++n) rb[nb][bj][n] = *(const GAS f32x4*)(q + bj * HALF + n * 16); }
                float ss = 0.f;
#pragma unroll
                for (int bj = 0; bj < 2; ++bj)
#pragma unroll
                    for (int n = 0; n < 2; ++n) { const f32x4 x1 = rb[cb][bj][n] + g[bj][n] * acc[ai][bj][m][n]; acc[ai][bj][m][n] = x1;
                        ss += (x1.x * x1.x + x1.y * x1.y) + (x1.z * x1.z + x1.w * x1.w); }
                ss += __int_as_float(__builtin_amdgcn_ds_swizzle(__float_as_int(ss), 0x401F));
                ss = half_sum(ss);
                if (fq == 0) P[(ai * HALF + wr * 64 + m * 16 + fr) * 4 + wc] = ss;
                asm volatile("" ::: "memory");
            }
        }
        const int tid = (wr * 4 + wc) * 64 + fq * 16 + fr;
        const size_t grow0 = (size_t)u.rt * HALF;
        asm volatile("s_waitcnt lgkmcnt(0)" ::: "memory"); __builtin_amdgcn_s_barrier(); asm volatile("" ::: "memory");
        if (tid < nrows) { const f32x4 p4 = *(const LAS f32x4*)(P + tid * 4); const float tot = (p4.x + p4.y) + (p4.z + p4.w);
            __hip_atomic_store((unsigned*)(xbuf + (grow0 + tid) * 4 + u.pn), __float_as_uint(tot), __ATOMIC_RELAXED, __HIP_MEMORY_SCOPE_AGENT); }
        asm volatile("s_waitcnt vmcnt(0)" ::: "memory");
        unsigned* cp = (unsigned*)(cnt + u.rt * 16);
        if ((fq | fr) == 0) (void)__hip_atomic_fetch_add(cp, 1u, __ATOMIC_RELAXED, __HIP_MEMORY_SCOPE_AGENT);
        f32x4 nscv[2][2], nshv[2][2];
#pragma unroll
        for (int bj = 0; bj < 2; ++bj)
#pragma unroll
            for (int n = 0; n < 2; ++n) { nscv[bj][n] = *(const GAS f32x4*)(nsc + (size_t)bb * 6 * D + col0 + bj * HALF + n * 16); nshv[bj][n] = *(const GAS f32x4*)(nsh + (size_t)bb * 6 * D + col0 + bj * HALF + n * 16); }
        if (tid < 64) { unsigned sp = 0;
            while ((unsigned)__builtin_amdgcn_readfirstlane(__hip_atomic_load(cp, __ATOMIC_RELAXED, __HIP_MEMORY_SCOPE_AGENT)) < 32u && ++sp < (1u << 20)) __builtin_amdgcn_s_sleep(1);
            }
        asm volatile("s_waitcnt vmcnt(0) lgkmcnt(0)" ::: "memory"); __builtin_amdgcn_s_barrier(); asm volatile("" ::: "memory");
        if (tid < nrows) { const unsigned* sl = (const unsigned*)(xbuf + (grow0 + tid) * 4); float tot = 0.f;
#pragma unroll
            for (int t = 0; t < 4; ++t) tot += __uint_as_float(__hip_atomic_load(sl + t, __ATOMIC_RELAXED, __HIP_MEMORY_SCOPE_AGENT));
            S[tid] = __builtin_amdgcn_rsqf(tot * (1.f / D) + EPS); }
        asm volatile("s_waitcnt vmcnt(0) lgkmcnt(0)" ::: "memory"); __builtin_amdgcn_s_barrier(); asm volatile("" ::: "memory");
#pragma unroll
        for (int gi = 0; gi < 8; ++gi) {
            const int ai = gi >> 2, m = gi & 3;
            if (gi >= ngr) break;
            const int lr = ai * HALF + wr * 64 + m * 16 + fr;
            const float rs = S[lr];
            GAS bf16_t* hp = Hn + (grow0 + lr) * D + col0;
            GAS float* op = out + (size_t)(r0 + ai * HALF + m * 16) * D + col0;
#pragma unroll
            for (int bj = 0; bj < 2; ++bj)
#pragma unroll
                for (int n = 0; n < 2; ++n) { const f32x4 x1 = acc[ai][bj][m][n];
                    *(GAS f32x4*)(op + bj * HALF + n * 16) = x1;
                    const f32x4 h = x1 * rs * nscv[bj][n] + nshv[bj][n]; u32x2 w; w.x = pk2(h.x, h.y); w.y = pk2(h.z, h.w); *(GAS u32x2*)(hp + bj * HALF + n * 16) = w; }
        }
    }
};
struct EpiSwiglu {
    static constexpr bool PERM = true;
    __device__ static __forceinline__ bool zero_after(const Unit&) { return true; }
    GAS bf16_t* Hd;
    __device__ __forceinline__ void operator()(AccRef acc, const Unit& u, int wr, int wc, int fr, int fq) const {
        const int row0 = u.rt * HALF + wr * 64 + fr, col0 = u.pn * HALF + wc * 32 + 8 * fq;
#pragma unroll
        for (int ai = 0; ai < 2; ++ai)
#pragma unroll
            for (int m = 0; m < 4; ++m) { const size_t row = (size_t)(row0 + ai * HALF + m * 16);
                float o[8];
#pragma unroll
                for (int n = 0; n < 2; ++n)
#pragma unroll
                    for (int i = 0; i < 4; ++i) { const float a = acc[ai][0][m][n][i], b = acc[ai][1][m][n][i]; o[n * 4 + i] = a * sigm(a) * b; }
                u32x4 w; w.x = pk2(o[0], o[1]); w.y = pk2(o[2], o[3]); w.z = pk2(o[4], o[5]); w.w = pk2(o[6], o[7]);
                *(GAS u32x4*)(Hd + row * DFF + col0) = w; }
    }
};
}

struct Args { const float* in[21]; float* out; unsigned char* ws; int ph_lo, ph_hi; };
enum { I_X = 0, I_C, I_CTX, I_CCTX, I_WADA, I_BADA, I_N1W, I_WIN, I_POOLW, I_POOLS, I_QNW, I_KNW, I_LB, I_HGNW, I_WBP, I_WBA, I_WBH, I_WOUT, I_N2W, I_W1, I_W2 };

__device__ __forceinline__ void transpose_item(const GAS float* W, int N, GAS bf16_t* WT, int ldt, int koff, int mode, LAS float* scr, int kb, int nb, int lane) {
    const int k0 = 64 * kb, n0 = 32 * nb;
#pragma unroll 8
    for (int i = 0; i < 32; ++i) { const int kk = 2 * i + (lane >> 5); scr[kk * 33 + (lane & 31)] = W[(size_t)(k0 + kk) * N + n0 + (lane & 31)]; }
    LDS_WAIT();
    const int c = lane & 7;
#pragma unroll
    for (int j = 0; j < 4; ++j) { const int n = (lane >> 3) + 8 * j; const LAS float* s = scr + (8 * c) * 33 + n;
        u32x4 o; o.x = pk2(s[0 * 33], s[1 * 33]); o.y = pk2(s[2 * 33], s[3 * 33]); o.z = pk2(s[4 * 33], s[5 * 33]); o.w = pk2(s[6 * 33], s[7 * 33]);
        const int nn = n0 + n; int drow = nn;
        if (mode == 1) { const int half = nn >= DFF ? 1 : 0; const int n2 = nn - half * DFF; drow = (n2 >> 7) * 256 + half * 128 + (n2 & 127); }
        *(GAS u32x4*)(WT + (size_t)drow * ldt + koff + k0 + 8 * c) = o; }
    LDS_WAIT();
}

__device__ __forceinline__ void convert_layer(const Args& a, LAS unsigned char* lds, int l, int gw, int NGW, int part, int nparts) {
    const int tid = tid_opq(), lane = tid & 63, wid = tid >> 6;
    GAS unsigned char* ws = (GAS unsigned char*)a.ws;
    LAS float* scr = (LAS float*)(lds + wid * 8448);
    GAS unsigned char* wl = ws + WS_W + l * W_LAYER;
    for (int it = gw * nparts + part; it < 7808; it += NGW * nparts) {
        int r = it;
        if (r < 2688) { transpose_item(GIN(I_WIN) + (size_t)l * D * NIN, NIN, (GAS bf16_t*)(wl + WO_IN), D, 0, 0, scr, r / 168, r % 168, lane); continue; } r -= 2688;
        if (r < 256) { transpose_item(GIN(I_WBA) + (size_t)l * 512 * D, D, (GAS bf16_t*)(wl + WO_MG), D, 256, 0, scr, r / 32, r % 32, lane); continue; } r -= 256;
        if (r < 128) { transpose_item(GIN(I_WBH) + (size_t)l * 256 * D, D, (GAS bf16_t*)(wl + WO_MG), D, 768, 0, scr, r / 32, r % 32, lane); continue; } r -= 128;
        if (r < 512) { transpose_item(GIN(I_WOUT) + (size_t)l * D * D, D, (GAS bf16_t*)(wl + WO_O), D, 0, 0, scr, r / 32, r % 32, lane); continue; } r -= 512;
        if (r < 2816) { transpose_item(GIN(I_W1) + (size_t)l * D * NFF, NFF, (GAS bf16_t*)(wl + WO_1), D, 0, 1, scr, r / 176, r % 176, lane); continue; } r -= 2816;
        transpose_item(GIN(I_W2) + (size_t)l * DFF * D, D, (GAS bf16_t*)(wl + WO_2), DFF, 0, 0, scr, r / 32, r % 32, lane);
    }
}

__device__ __forceinline__ void phase_prologue(const Args& a, LAS unsigned char* lds, int G) {
    const int tid = tid_opq(), lane = tid & 63, wid = tid >> 6;
    GAS unsigned char* ws = ((GAS unsigned char*)a.ws); ASSUME_GLOBAL(ws); ASSUME_GLOBAL(((GAS float*)a.out));
#pragma unroll
    for (int i = 0; i < 21; ++i) ASSUME_GLOBAL(GIN(i));
    LAS float* sa = (LAS float*)(lds + 73728);
    for (int i = tid; i < 9 * D; i += NTHR) { const float v = i < 8 * D ? GIN(I_C)[i] : GIN(I_CCTX)[i - 8 * D]; sa[i] = v * sigm(v); }
    __syncthreads();
    {
        GAS float* modp = (GAS float*)(ws + WS_MODP);
        for (int idx = blockIdx.x * NTHR + tid; idx < 8 * 4 * 3072; idx += G * NTHR) {
            const int j = 2 * (idx % 3072), l = (idx / 3072) & 3, ks = idx / (3072 * 4);
            const GAS float* w = GIN(I_WADA) + ((size_t)l * D + ks * 128) * 6144 + j;
            f32x2 acc[9];
#pragma unroll
            for (int b = 0; b < 9; ++b) acc[b] = (f32x2){0.f, 0.f};
#pragma unroll 8
            for (int k = 0; k < 128; ++k) { const f32x2 wv = *(const GAS f32x2*)(w + (size_t)k * 6144);
#pragma unroll
                for (int b = 0; b < 9; ++b) acc[b] += wv * sa[b * D + ks * 128 + k]; }
#pragma unroll
            for (int b = 0; b < 9; ++b) *(GAS f32x2*)(modp + ((size_t)(ks * 4 + l) * 9 + b) * 6144 + j) = acc[b];
        }
    }
    for (int idx = blockIdx.x * NTHR + tid; idx < 4 * 32 * 1024; idx += G * NTHR) {
        const int n = idx & 1023, hi = __builtin_amdgcn_readfirstlane(idx >> 10), c8 = hi & 31, l = hi >> 5, g = c8 >> 3;
        const GAS float* pw = GIN(I_POOLW) + ((size_t)l * 256 + 8 * c8) * 64;
        const GAS float* ps = GIN(I_POOLS) + l * 256 + g * 64;
        const GAS float* wb = GIN(I_WBP) + ((size_t)l * 256 + g * 64) * D + n;
        float sacc[8];
#pragma unroll
        for (int j = 0; j < 8; ++j) sacc[j] = 0.f;
#pragma unroll 16
        for (int d = 0; d < 64; ++d) { const float x = ps[d] * wb[(size_t)d * D];
#pragma unroll
            for (int j = 0; j < 8; ++j) sacc[j] += pw[j * 64 + d] * x; }
        GAS bf16_t* wt = (GAS bf16_t*)(ws + WS_W + l * W_LAYER + WO_MG);
        u32x4 o; o.x = pk2(sacc[0], sacc[1]); o.y = pk2(sacc[2], sacc[3]); o.z = pk2(sacc[4], sacc[5]); o.w = pk2(sacc[6], sacc[7]);
        *(GAS u32x4*)(wt + (size_t)n * D + 8 * c8) = o;
    }
    {
        GAS float* sm = (GAS float*)(ws + WS_SM);
        if (blockIdx.x == 0) for (int i = tid; i < SM_N; i += NTHR)
            sm[i] = i < SM_KNW ? GIN(I_QNW)[i] : i < SM_LB ? GIN(I_KNW)[i - SM_KNW] : i < SM_HGNW ? GIN(I_LB)[i - SM_LB] : GIN(I_HGNW)[i - SM_HGNW];
    }
    convert_layer(a, lds, 0, blockIdx.x * 8 + wid, G * 8, 0, 1);
}

__device__ __forceinline__ void phase_modfinal(const Args& a, int G) {
    ASSUME_GLOBAL(((GAS unsigned char*)a.ws)); ASSUME_GLOBAL(GIN(I_BADA)); ASSUME_GLOBAL(GIN(I_N1W)); ASSUME_GLOBAL(GIN(I_N2W));
    const GAS float* modp = (const GAS float*)(((GAS unsigned char*)a.ws) + WS_MODP); GAS float* modf = (GAS float*)(((GAS unsigned char*)a.ws) + WS_MODF);
    const int tid = tid_opq();
    for (int idx = blockIdx.x * NTHR + tid; idx < 4 * 9 * 6144; idx += G * NTHR) {
        const int j = idx % 6144, b = (idx / 6144) % 9, l = idx / (6144 * 9), s = j >> 10, i = j & 1023;
        float v = GIN(I_BADA)[l * 6144 + j];
#pragma unroll
        for (int ks = 0; ks < 8; ++ks) v += modp[((size_t)(ks * 4 + l) * 9 + b) * 6144 + j];
        if (s == 1) v = GIN(I_N1W)[l * D + i] * (1.f + v);
        if (s == 4) v = GIN(I_N2W)[l * D + i] * (1.f + v);
        modf[idx] = v;
    }
}

__device__ __forceinline__ void phase_norm(const GAS float* srcL, const GAS float* srcC, GAS bf16_t* H, const GAS float* modf_l, int s_scale, int s_shift, int M, int G) {
    const int tid = tid_opq(), lane = tid & 63, wid = tid >> 6;
    int row = wid * G + blockIdx.x;
    if (row >= M) return;
    f32x4 v[4];
    { const GAS float* xr = row < ML ? srcL + (size_t)row * D : srcC + (size_t)(row - ML) * D;
#pragma unroll
      for (int j = 0; j < 4; ++j) v[j] = ((const GAS f32x4*)xr)[lane + 64 * j]; }
    for (;;) {
        const int nrow = row + G * 8; const bool more = nrow < M;
        f32x4 vn[4];
        if (more) { const GAS float* xr = nrow < ML ? srcL + (size_t)nrow * D : srcC + (size_t)(nrow - ML) * D;
#pragma unroll
            for (int j = 0; j < 4; ++j) vn[j] = ((const GAS f32x4*)xr)[lane + 64 * j]; }
        const int bb = row < ML ? (row >> 11) : 8;
        const GAS f32x4* sc = (const GAS f32x4*)(modf_l + (size_t)(bb * 6 + s_scale) * D); const GAS f32x4* sh = (const GAS f32x4*)(modf_l + (size_t)(bb * 6 + s_shift) * D);
        f32x4 scv[4], shv[4];
#pragma unroll
        for (int j = 0; j < 4; ++j) { scv[j] = sc[lane + 64 * j]; shv[j] = sh[lane + 64 * j]; }
        float ss = 0.f;
#pragma unroll
        for (int j = 0; j < 4; ++j) ss += (v[j].x * v[j].x + v[j].y * v[j].y) + (v[j].z * v[j].z + v[j].w * v[j].w);
        const float r = __builtin_amdgcn_rsqf(wave_sum(ss) * (1.f / D) + EPS);
        GAS u32x2* o = (GAS u32x2*)(H + (size_t)row * D);
#pragma unroll
        for (int j = 0; j < 4; ++j) { const f32x4 y = v[j] * r * scv[j] + shv[j]; u32x2 w; w.x = pk2(y.x, y.y); w.y = pk2(y.z, y.w); o[lane + 64 * j] = w; }
        if (!more) break;
#pragma unroll
        for (int j = 0; j < 4; ++j) v[j] = vn[j];
        row = nrow;
    }
}

__device__ __forceinline__ float half_max(float m) { auto rr = __builtin_amdgcn_permlane32_swap(__float_as_uint(m), __float_as_uint(m), false, false); return fmaxf(__uint_as_float(rr[0]), __uint_as_float(rr[1])); }
__device__ __forceinline__ float half_sum(float m) { auto rr = __builtin_amdgcn_permlane32_swap(__float_as_uint(m), __float_as_uint(m), false, false); return __uint_as_float(rr[0]) + __uint_as_float(rr[1]); }
constexpr size_t SB_OUT_OFF = (size_t)64 * NCH * 4096 * 2;
constexpr int HG_WL = 19712, HQ_OFF = 0, HK_OFF = 4608, HKH_OFF = 9216, HVT_OFF = 14336, HDEC_OFF = 19456;
#define MFMA32(a, b, c) __builtin_amdgcn_mfma_f32_32x32x16_bf16((a), (b), (c), 0, 0, 0)
__device__ __forceinline__ float hgrn_lb(const GAS float* lbl, int l, int dir, int col) {
    float x[4]; float mx = -1e30f;
#pragma unroll
    for (int i = 0; i < 4; ++i) { x[i] = lbl[(i * 2 + dir) * 256 + col]; mx = fmaxf(mx, x[i]); }
    float e[4], s = 0.f;
#pragma unroll
    for (int i = 0; i < 4; ++i) { e[i] = __expf(x[i] - mx); s += e[i]; }
    float c = 0.f;
#pragma unroll
    for (int i = 1; i < 4; ++i) if (i <= l) c += e[i];
    return c / s;
}
__device__ __forceinline__ bf16x8 pack8(const f32x16& x, int base) {
    u32x4 w; w.x = pk2(x[base], x[base + 1]); w.y = pk2(x[base + 2], x[base + 3]); w.z = pk2(x[base + 4], x[base + 5]); w.w = pk2(x[base + 6], x[base + 7]);
    return __builtin_bit_cast(bf16x8, w);
}
template <int DIR, bool FULL>
__device__ __forceinline__ float hg_prep(LAS unsigned char* wl, const GAS bf16_t* Pp, size_t row0, int hd, float lb, int lane) {
    const GAS bf16_t* pz = Pp + row0 * NP + (DIR ? PC_ZB : PC_ZF) + hd * 64 + lane;
    const GAS bf16_t* pq = Pp + row0 * NP + PC_HQ + hd * 64 + lane;
    const GAS bf16_t* pv = Pp + row0 * NP + PC_HI + hd * 64 + lane;
    unsigned vp[16];
#pragma unroll
    for (int c = 0; c < 16; ++c) vp[c] = (unsigned)pv[(size_t)(2 * c) * NP] | ((unsigned)pv[(size_t)(2 * c + 1) * NP] << 16);
    unsigned ktp[16]; float Dc = 1.f;
#pragma unroll
    for (int i = 0; i < 16; ++i) ktp[i] = 0u;
    bf16_t zr[2][8], qr[2][8];
#pragma unroll
    for (int i = 0; i < 8; ++i) { const int t = DIR ? 31 - i : i; zr[0][i] = pz[(size_t)t * NP]; if (FULL) qr[0][i] = pq[(size_t)t * NP]; }
#pragma unroll
    for (int g = 0; g < 4; ++g) {
        if (g < 3) {
#pragma unroll
            for (int i = 0; i < 8; ++i) { const int t = DIR ? 31 - (8 * (g + 1) + i) : 8 * (g + 1) + i; zr[(g + 1) & 1][i] = pz[(size_t)t * NP]; if (FULL) qr[(g + 1) & 1][i] = pq[(size_t)t * NP]; }
        }
#pragma unroll
        for (int i = 0; i < 8; ++i) {
            const int t = DIR ? 31 - (8 * g + i) : 8 * g + i;
            float z = bf2f(zr[g & 1][i]); z = fminf(fmaxf(z, -30.f), 30.f);
            const float e = __builtin_amdgcn_exp2f(z * -1.4426950408889634f); const float sg = __builtin_amdgcn_rcpf(1.f + e);
            const float f = lb + (1.f - lb) * sg; const float kkv = (1.f - lb) * (e * sg);
            Dc = fmaxf(Dc * f, 1e-30f);
            const float kti = kkv * __builtin_amdgcn_rcpf(Dc);
            const unsigned ktb = f2bf(kti); ktp[t >> 1] |= (t & 1) ? (ktb << 16) : ktb;
            if (FULL) { const float q = bf2f(qr[g & 1][i]);
                *(LAS bf16_t*)(wl + HQ_OFF + t * 144 + lane * 2) = (bf16_t)f2bf(q * Dc); *(LAS bf16_t*)(wl + HK_OFF + t * 144 + lane * 2) = (bf16_t)ktb; }
        }
        __builtin_amdgcn_sched_barrier(0);
    }
#pragma unroll
    for (int c = 0; c < 4; ++c) { u32x4 w;
#pragma unroll
        for (int i = 0; i < 4; ++i) { const unsigned p = ktp[4 * c + i]; w[i] = pk2(__uint_as_float(p << 16) * Dc, __uint_as_float(p & 0xffff0000u) * Dc); }
        *(LAS u32x4*)(wl + HKH_OFF + lane * 80 + c * 16) = w; }
    *(LAS float*)(wl + HDEC_OFF + lane * 4) = Dc;
#pragma unroll
    for (int c = 0; c < 4; ++c) *(LAS u32x4*)(wl + HVT_OFF + lane * 80 + c * 16) = (u32x4){vp[4 * c], vp[4 * c + 1], vp[4 * c + 2], vp[4 * c + 3]};
    return Dc;
}
__device__ __forceinline__ void hg_update(LAS unsigned char* wl, f32x16 (&S)[2][2], int n, int h) {
#pragma unroll
    for (int kt = 0; kt < 2; ++kt) {
        f32x4 d4[4];
#pragma unroll
        for (int g = 0; g < 4; ++g) d4[g] = *(const LAS f32x4*)(wl + HDEC_OFF + (32 * kt + 8 * g + 4 * h) * 4);
        bf16x8 ka[2];
#pragma unroll
        for (int st = 0; st < 2; ++st) ka[st] = *(const LAS bf16x8*)(wl + HKH_OFF + (32 * kt + n) * 80 + (16 * st + 8 * h) * 2);
#pragma unroll
        for (int ct = 0; ct < 2; ++ct) {
#pragma unroll
            for (int g = 0; g < 4; ++g)
#pragma unroll
                for (int i = 0; i < 4; ++i) S[kt][ct][4 * g + i] *= d4[g][i];
#pragma unroll
            for (int st = 0; st < 2; ++st) { const bf16x8 vb = *(const LAS bf16x8*)(wl + HVT_OFF + (32 * ct + n) * 80 + (16 * st + 8 * h) * 2);
                S[kt][ct] = MFMA32(ka[st], vb, S[kt][ct]); }
        }
    }
}
template <int DIR>
__device__ __forceinline__ float hg_out(LAS unsigned char* wl, const f32x16 (&S)[2][2], int n, int h, GAS bf16_t* odst) {
    f32x16 at;
#pragma unroll
    for (int r = 0; r < 16; ++r) at[r] = 0.f;
#pragma unroll
    for (int ks = 0; ks < 4; ++ks) { const bf16x8 a = *(const LAS bf16x8*)(wl + HK_OFF + n * 144 + ks * 32 + h * 16), b = *(const LAS bf16x8*)(wl + HQ_OFF + n * 144 + ks * 32 + h * 16);
        at = MFMA32(a, b, at); }
#pragma unroll
    for (int r = 0; r < 16; ++r) { const int sidx = (r & 3) + 8 * (r >> 2) + 4 * h; const bool keep = DIR ? (sidx >= n) : (sidx <= n); at[r] = keep ? at[r] : 0.f; }
    const bf16x8 xs0 = pack8(at, 0), xs1 = pack8(at, 8);
    float ss = 0.f;
#pragma unroll
    for (int vt = 0; vt < 2; ++vt) {
        f32x16 Ov;
#pragma unroll
        for (int r = 0; r < 16; ++r) Ov[r] = 0.f;
#pragma unroll
        for (int st = 0; st < 2; ++st) { const LAS unsigned char* vp = wl + HVT_OFF + (32 * vt + n) * 80 + (16 * st + 4 * h) * 2;
            const u32x2 lo = *(const LAS u32x2*)vp, hi2 = *(const LAS u32x2*)(vp + 16);
            Ov = MFMA32(__builtin_bit_cast(bf16x8, (u32x4){lo.x, lo.y, hi2.x, hi2.y}), st ? xs1 : xs0, Ov); }
#pragma unroll
        for (int kt = 0; kt < 2; ++kt)
#pragma unroll
            for (int st = 0; st < 2; ++st) { const LAS unsigned char* qp = wl + HQ_OFF + n * 144 + (32 * kt + 16 * st + 4 * h) * 2;
                const u32x2 lo = *(const LAS u32x2*)qp, hi2 = *(const LAS u32x2*)(qp + 16);
                Ov = MFMA32(pack8(S[kt][vt], 8 * st), __builtin_bit_cast(bf16x8, (u32x4){lo.x, lo.y, hi2.x, hi2.y}), Ov); }
#pragma unroll
        for (int g = 0; g < 4; ++g) {
            float o[4] = {Ov[4 * g], Ov[4 * g + 1], Ov[4 * g + 2], Ov[4 * g + 3]};
            if (DIR == 1) { const u32x2 pw = *(const GAS u32x2*)(odst + 32 * vt + 8 * g);
                o[0] += __uint_as_float(pw.x << 16); o[1] += __uint_as_float(pw.x & 0xffff0000u); o[2] += __uint_as_float(pw.y << 16); o[3] += __uint_as_float(pw.y & 0xffff0000u);
                ss += (o[0] * o[0] + o[1] * o[1]) + (o[2] * o[2] + o[3] * o[3]); }
            u32x2 w; w.x = pk2(o[0], o[1]); w.y = pk2(o[2], o[3]); *(GAS u32x2*)(odst + 32 * vt + 8 * g) = w; }
        __builtin_amdgcn_sched_barrier(0);
    }
    return ss;
}
__device__ __forceinline__ size_t hg_row0(int b, int cidx) { return cidx < 4 ? (size_t)(ML + b * LCTX + cidx * 64) : (size_t)(b * SEQ + (cidx - 4) * 64); }
template <int DIR>
__device__ __forceinline__ void hgrn_passA_dir(int bh, int cidx, int l, GAS unsigned char* ws, LAS unsigned char* wl, int lane) {
    const int b = bh >> 2, hd = bh & 3, n = lane & 31, h = lane >> 5;
    const GAS bf16_t* Pp = (const GAS bf16_t*)(ws + WS_PP); GAS float* SB = (GAS float*)(ws + WS_H); GAS float* AV = (GAS float*)(ws + WS_AV);
    const float lb = hgrn_lb((const GAS float*)(ws + WS_SM) + SM_LB, l, DIR, hd * 64 + lane);
    const size_t row0 = hg_row0(b, cidx);
    f32x16 S[2][2];
#pragma unroll
    for (int i = 0; i < 4; ++i)
#pragma unroll
        for (int r = 0; r < 16; ++r) S[i >> 1][i & 1][r] = 0.f;
    float dtot = 1.f;
#pragma unroll
    for (int si = 0; si < 2; ++si) {
        const int sub = DIR ? 1 - si : si;
        dtot *= hg_prep<DIR, false>(wl, Pp, row0 + 32 * sub, hd, lb, lane);
        LDS_WAIT();
        hg_update(wl, S, n, h);
        LDS_WAIT();
    }
    const size_t sidx = (size_t)(bh * 2 + DIR) * NCH + cidx;
    GAS bf16_t* sb = (GAS bf16_t*)SB + sidx * 4096 + (size_t)n * 64 + 4 * h;
#pragma unroll
    for (int kt = 0; kt < 2; ++kt)
#pragma unroll
        for (int ct = 0; ct < 2; ++ct)
#pragma unroll
            for (int g = 0; g < 4; ++g) { u32x2 w; w.x = pk2(S[kt][ct][4 * g], S[kt][ct][4 * g + 1]); w.y = pk2(S[kt][ct][4 * g + 2], S[kt][ct][4 * g + 3]);
                *(GAS u32x2*)(sb + (32 * ct) * 64 + 32 * kt + 8 * g) = w; }
    AV[sidx * 64 + lane] = dtot;
}
template <int DIR>
__device__ __forceinline__ void hgrn_passC_dir(int bh, int cidx, int l, GAS unsigned char* ws, LAS unsigned char* wl, int lane) {
    const int b = bh >> 2, hd = bh & 3, n = lane & 31, h = lane >> 5;
    const GAS bf16_t* Pp = (const GAS bf16_t*)(ws + WS_PP); const GAS float* SB = (const GAS float*)(ws + WS_H); const GAS float* AV = (const GAS float*)(ws + WS_AV);
    GAS bf16_t* MO = (GAS bf16_t*)(ws + WS_MO); const GAS float* sm = (const GAS float*)(ws + WS_SM);
    const float lb = hgrn_lb(sm + SM_LB, l, DIR, hd * 64 + lane);
    const size_t row0 = hg_row0(b, cidx);
    f32x16 S[2][2];
#pragma unroll
    for (int i = 0; i < 4; ++i)
#pragma unroll
        for (int r = 0; r < 16; ++r) S[i >> 1][i & 1][r] = 0.f;
    {
        const size_t sidx = (size_t)(bh * 2 + DIR) * NCH + cidx;
        const GAS bf16_t* sb = (const GAS bf16_t*)((const GAS unsigned char*)SB + SB_OUT_OFF) + sidx * 4096 + (size_t)n * 64 + 4 * h; asm volatile("" : "+v"(sb)); ASSUME_GLOBAL(sb);
#pragma unroll
        for (int kt = 0; kt < 2; ++kt)
#pragma unroll
            for (int ct = 0; ct < 2; ++ct)
#pragma unroll
                for (int g = 0; g < 4; ++g) { const u32x2 w = *(const GAS u32x2*)(sb + (32 * ct) * 64 + 32 * kt + 8 * g);
                    S[kt][ct][4 * g] = __uint_as_float(w.x << 16); S[kt][ct][4 * g + 1] = __uint_as_float(w.x & 0xffff0000u); S[kt][ct][4 * g + 2] = __uint_as_float(w.y << 16); S[kt][ct][4 * g + 3] = __uint_as_float(w.y & 0xffff0000u); }
    }
#pragma unroll
    for (int si = 0; si < 2; ++si) {
        const int sub = DIR ? 1 - si : si;
        int lane_o = lane; asm volatile("" : "+v"(lane_o));
        const int lane = lane_o, n = lane & 31, h = lane >> 5;
        GAS unsigned char* ws_o = ws; asm volatile("" : "+s"(ws_o)); ASSUME_GLOBAL(ws_o);
        const GAS bf16_t* Pp = (const GAS bf16_t*)(ws_o + WS_PP); GAS bf16_t* MO = (GAS bf16_t*)(ws_o + WS_MO); const GAS float* sm = (const GAS float*)(ws_o + WS_SM);
        const size_t row0s = hg_row0(b, cidx) + 32 * sub;
        __builtin_amdgcn_sched_barrier(0);
        hg_prep<DIR, true>(wl, Pp, row0s, hd, lb, lane);
        LDS_WAIT();
        __builtin_amdgcn_sched_barrier(0);
        GAS bf16_t* odst = MO + (row0s + n) * D + MO_HG + hd * 64 + 4 * h;
        float ss = hg_out<DIR>(wl, S, n, h, odst);
        __builtin_amdgcn_sched_barrier(0);
        hg_update(wl, S, n, h);
        LDS_WAIT();
        __builtin_amdgcn_sched_barrier(0);
        if (DIR == 1) {
            const size_t row = row0s + n;
            ss = half_sum(ss);
            const float rstd = __builtin_amdgcn_rsqf(ss * (1.f / 64.f) + EPS);
#pragma unroll
            for (int vt = 0; vt < 2; ++vt)
#pragma unroll
                for (int g = 0; g < 4; ++g) { const int cb = 32 * vt + 8 * g + 4 * h;
                    const u32x2 pw = *(const GAS u32x2*)(odst + 32 * vt + 8 * g);
                    const u32x2 gw = *(const GAS u32x2*)(Pp + row * NP + PC_HG + hd * 64 + cb);
                    const f32x4 nw4 = *(const GAS f32x4*)(sm + SM_HGNW + l * 64 + cb);
                    const float g0 = __uint_as_float(gw.x << 16), g1 = __uint_as_float(gw.x & 0xffff0000u), g2 = __uint_as_float(gw.y << 16), g3 = __uint_as_float(gw.y & 0xffff0000u);
                    u32x2 w; w.x = pk2(__uint_as_float(pw.x << 16) * rstd * nw4[0] * (g0 * sigm(g0)), __uint_as_float(pw.x & 0xffff0000u) * rstd * nw4[1] * (g1 * sigm(g1)));
                    w.y = pk2(__uint_as_float(pw.y << 16) * rstd * nw4[2] * (g2 * sigm(g2)), __uint_as_float(pw.y & 0xffff0000u) * rstd * nw4[3] * (g3 * sigm(g3)));
                    *(GAS u32x2*)(odst + 32 * vt + 8 * g) = w;
                    if (g == 3) asm volatile("" ::: "memory"); }
        }
    }
}
__device__ __forceinline__ void hgrn_passA(int task, int l, GAS unsigned char* ws, LAS unsigned char* lds) {
    const int tid = tid_opq(), lane = tid & 63, wid = tid >> 6;
    LAS unsigned char* wl = lds + wid * HG_WL;
    const int dir = task & 1, t2 = task >> 1, cidx = t2 % NCH, bh = t2 / NCH;
    if (dir) hgrn_passA_dir<1>(bh, cidx, l, ws, wl, lane); else hgrn_passA_dir<0>(bh, cidx, l, ws, wl, lane);
}
__device__ __forceinline__ void hgrn_passC(int task, int l, GAS unsigned char* ws, LAS unsigned char* lds) {
    const int tid = tid_opq(), lane = tid & 63, wid = tid >> 6;
    LAS unsigned char* wl = lds + wid * HG_WL;
    const int cidx = task % NCH, bh = task / NCH;
    if (l == DEPTH - 1 && cidx < 4) return;
#ifndef HGC_MASK
#define HGC_MASK 3
#endif
    if (HGC_MASK & 1) hgrn_passC_dir<0>(bh, cidx, l, ws, wl, lane);
    if (HGC_MASK & 2) hgrn_passC_dir<1>(bh, cidx, l, ws, wl, lane);
}

__device__ __forceinline__ void prep_run(int m0, int cnt, int l, GAS unsigned char* ws, bool dry) {
    const int lane = tid_opq() & 63, li = lane & 15, hq = lane >> 4;
    GAS bf16_t* Pp = (GAS bf16_t*)(ws + WS_PP); GAS bf16_t* MO = (GAS bf16_t*)(ws + WS_MO); const GAS float* sm = (const GAS float*)(ws + WS_SM);
    const bool lowhalf = (li & 4) == 0;
    int cbv[3]; bool actv[3];
#pragma unroll
    for (int ps = 0; ps < 3; ++ps) { const int hh = ps * 4 + hq; actv[ps] = hh < 10; const int hc = actv[ps] ? hh : 9; cbv[ps] = (hc < 8 ? PC_Q + hc * 64 : PC_K + (hc - 8) * 64) + 4 * li; }
    f32x4 w4[3];
#pragma unroll
    for (int ps = 0; ps < 3; ++ps) w4[ps] = *(const GAS f32x4*)(sm + ((ps * 4 + hq) < 8 ? SM_QNW : SM_KNW) + l * 64 + 4 * li);
    u32x2 rawn[3];
#pragma unroll
    for (int ps = 0; ps < 3; ++ps) rawn[ps] = *(const GAS u32x2*)(Pp + (size_t)m0 * NP + cbv[ps]);
    const int w2 = 1 << (lane >> 4);
    float s0 = 0.f, s1 = 0.f, s2 = 0.f, s3 = 0.f; int lo = 0, hi = 0;
#pragma unroll 1
    for (int i = 0; i < cnt; ++i) {
        const int m = m0 + i;
        const bool isc = m >= ML; const int t = isc ? ((m - ML) & 255) : (m & 2047);
        GAS bf16_t* pr = Pp + (size_t)m * NP;
        u32x2 raw[3];
#pragma unroll
        for (int ps = 0; ps < 3; ++ps) raw[ps] = rawn[ps];
        if (i + 1 < cnt) {
#pragma unroll
            for (int ps = 0; ps < 3; ++ps) rawn[ps] = *(const GAS u32x2*)(pr + NP + cbv[ps]);
        }
        const int Lseg = isc ? LCTX : SEQ;
        const int nlo = t - w2 < 0 ? 0 : t - w2, nhi = t + w2 > Lseg ? Lseg : t + w2;
        const GAS bf16_t* seg = Pp + (size_t)(m - t) * NP + 4 * lane;
        const u32x2 uself = *(const GAS u32x2*)(seg + (size_t)t * NP);
        if (i == 0 || t == 0) {
            s0 = 0.f; s1 = 0.f; s2 = 0.f; s3 = 0.f;
#pragma unroll 4
            for (int tt = nlo; tt < nhi; ++tt) { const u32x2 u = *(const GAS u32x2*)(seg + (size_t)tt * NP);
                s0 += __uint_as_float(u.x << 16); s1 += __uint_as_float(u.x & 0xffff0000u); s2 += __uint_as_float(u.y << 16); s3 += __uint_as_float(u.y & 0xffff0000u); }
        } else {
            const bool add = nhi > hi, rem = nlo > lo;
            u32x2 ua = {0u, 0u}, ur = {0u, 0u};
            if (add) ua = *(const GAS u32x2*)(seg + (size_t)(nhi - 1) * NP);
            if (rem) ur = *(const GAS u32x2*)(seg + (size_t)lo * NP);
            s0 += __uint_as_float(ua.x << 16) - __uint_as_float(ur.x << 16); s1 += __uint_as_float(ua.x & 0xffff0000u) - __uint_as_float(ur.x & 0xffff0000u);
            s2 += __uint_as_float(ua.y << 16) - __uint_as_float(ur.y << 16); s3 += __uint_as_float(ua.y & 0xffff0000u) - __uint_as_float(ur.y & 0xffff0000u);
        }
        lo = nlo; hi = nhi;
        float cs[4], sn[4];
        const float pos = (float)((li < 8) ? (t >> 6) : (t & 63));
#pragma unroll
        for (int j = 0; j < 4; ++j) { const int i16 = (4 * li + j) & 15; const float ang = pos * __builtin_amdgcn_exp2f(-(float)i16 * (13.287712379549449f / 16.f)); cs[j] = __cosf(ang); sn[j] = __sinf(ang); }
#pragma unroll
        for (int ps = 0; ps < 3; ++ps) {
            const bool isq = (ps * 4 + hq) < 8;
            float x[4] = {__uint_as_float(raw[ps].x << 16), __uint_as_float(raw[ps].x & 0xffff0000u), __uint_as_float(raw[ps].y << 16), __uint_as_float(raw[ps].y & 0xffff0000u)};
            const float ss = row16_sum((x[0] * x[0] + x[1] * x[1]) + (x[2] * x[2] + x[3] * x[3]));
            const float r = __builtin_amdgcn_rsqf(ss * (1.f / 64.f) + EPS);
            float y[4];
#pragma unroll
            for (int j = 0; j < 4; ++j) { y[j] = x[j] * r * w4[ps][j]; const float p = __int_as_float(__builtin_amdgcn_ds_swizzle(__float_as_int(y[j]), 0x101F));
                if (!isc) y[j] = lowhalf ? (y[j] * cs[j] - p * sn[j]) : (y[j] * cs[j] + p * sn[j]); if (isq) y[j] *= 0.125f * 1.4426950408889634f; }
            u32x2 o; o.x = pk2(y[0], y[1]); o.y = pk2(y[2], y[3]);
            if (actv[ps]) *(GAS u32x2*)((dry ? (GAS bf16_t*)(ws + WS_MODP) + (size_t)(m & 1023) * NP : pr) + cbv[ps]) = o;
        }
        const float inv = __builtin_amdgcn_rcpf((float)(nhi - nlo));
        u32x2 o; o.x = pk2(s0 * inv - __uint_as_float(uself.x << 16), s1 * inv - __uint_as_float(uself.x & 0xffff0000u));
        o.y = pk2(s2 * inv - __uint_as_float(uself.y << 16), s3 * inv - __uint_as_float(uself.y & 0xffff0000u));
        *(GAS u32x2*)(MO + (size_t)m * D + MO_POOL + 4 * lane) = o;
    }
}
__device__ __forceinline__ void vt_task(int task, GAS unsigned char* ws) {
    const int lane = tid_opq() & 63;
    const GAS bf16_t* Pp = (const GAS bf16_t*)(ws + WS_PP); GAS bf16_t* Vt = (GAS bf16_t*)(ws + WS_VT);
    const int j = task % 36, bk = task / 36, b = bk >> 1, kvh = bk & 1;
    const size_t row0 = j < 32 ? (size_t)(b * SEQ + j * 64) : (size_t)(ML + b * LCTX + (j - 32) * 64);
    const GAS bf16_t* pv = Pp + row0 * NP + PC_V + kvh * 64 + lane;
    GAS bf16_t* dst = Vt + ((size_t)bk * 64 + lane) * SKV + j * 64;
#pragma unroll
    for (int c = 0; c < 8; ++c) { u32x4 w;
        w.x = (unsigned)pv[(size_t)(8 * c) * NP] | ((unsigned)pv[(size_t)(8 * c + 1) * NP] << 16); w.y = (unsigned)pv[(size_t)(8 * c + 2) * NP] | ((unsigned)pv[(size_t)(8 * c + 3) * NP] << 16);
        w.z = (unsigned)pv[(size_t)(8 * c + 4) * NP] | ((unsigned)pv[(size_t)(8 * c + 5) * NP] << 16); w.w = (unsigned)pv[(size_t)(8 * c + 6) * NP] | ((unsigned)pv[(size_t)(8 * c + 7) * NP] << 16);
        *(GAS u32x4*)(dst + 8 * c) = w; }
}

constexpr int KV_BUF = 9216 + 8704;
__device__ __forceinline__ void attn_unit(LAS unsigned char* lds, const GAS bf16_t* Pp, const GAS bf16_t* Vt, GAS bf16_t* MO, int b, int kvh, int rowbase, int wstride, int offB, int headA, int headB, int key0, int ntiles) {
    const int tid = tid_opq(), lane = tid & 63, wid = tid >> 6, r32 = lane & 31, hi = lane >> 5;
    size_t qrow[2]; int hd[2];
    qrow[0] = (size_t)(rowbase + wid * wstride + r32); qrow[1] = qrow[0] + offB; hd[0] = headA; hd[1] = headB;
    bf16x8 qr[2][4];
#pragma unroll
    for (int qb = 0; qb < 2; ++qb)
#pragma unroll
        for (int d0 = 0; d0 < 4; ++d0) qr[qb][d0] = *(const GAS bf16x8*)(Pp + qrow[qb] * NP + PC_Q + hd[qb] * 64 + d0 * 16 + hi * 8);
    const int lk = tid >> 3, lc = tid & 7;
    const GAS bf16_t* vsrc = Vt + ((size_t)(b * 2 + kvh) * 64 + lk) * SKV + lc * 8;
    const GAS bf16_t* kcol = Pp + PC_K + kvh * 64 + lc * 8;
    u32x4 kreg, vreg;
    auto load_tile = [&](int j) {
        const int s = key0 + j * 64 + lk;
        const size_t kr = s < SEQ ? (size_t)(b * SEQ + s) : (size_t)(ML + b * LCTX + (s - SEQ));
        kreg = *(const GAS u32x4*)(kcol + kr * NP);
        vreg = *(const GAS u32x4*)(vsrc + key0 + j * 64);
    };
    auto store_tile = [&](int buf) {
        LAS unsigned char* kb = lds + buf * KV_BUF;
        *(LAS u32x4*)(kb + lk * 144 + lc * 16) = kreg;
        LAS unsigned char* vb = kb + 9216 + lk * 136 + lc * 16;
        *(LAS u32x2*)(vb) = (u32x2){vreg.x, vreg.y}; *(LAS u32x2*)(vb + 8) = (u32x2){vreg.z, vreg.w};
    };
    load_tile(0); store_tile(0);
    __syncthreads();
    f32x16 o[2][2], negm[2];
#pragma unroll
    for (int qb = 0; qb < 2; ++qb)
#pragma unroll
        for (int r = 0; r < 16; ++r) { o[qb][0][r] = 0.f; o[qb][1][r] = 0.f; negm[qb][r] = 0.f; }
    float mrun[2] = {0.f, 0.f}, lrun[2] = {0.f, 0.f};
    for (int j = 0; j < ntiles; ++j) {
        const int buf = j & 1;
        if (j + 1 < ntiles) load_tile(j + 1);
        const LAS unsigned char* kb = lds + buf * KV_BUF + r32 * 144 + hi * 16;
        f32x16 p[2][2];
#pragma unroll
        for (int d0 = 0; d0 < 4; ++d0) {
            const bf16x8 a0 = *(const LAS bf16x8*)(kb + d0 * 32), a1 = *(const LAS bf16x8*)(kb + 32 * 144 + d0 * 32);
#pragma unroll
            for (int qb = 0; qb < 2; ++qb) {
                p[qb][0] = __builtin_amdgcn_mfma_f32_32x32x16_bf16(a0, qr[qb][d0], d0 == 0 ? negm[qb] : p[qb][0], 0, 0, 0);
                p[qb][1] = __builtin_amdgcn_mfma_f32_32x32x16_bf16(a1, qr[qb][d0], d0 == 0 ? negm[qb] : p[qb][1], 0, 0, 0);
            }
        }
#pragma unroll
        for (int qb = 0; qb < 2; ++qb) {
            f32x16& p0 = p[qb][0]; f32x16& p1 = p[qb][1];
            float ma = __builtin_fmaxf(__builtin_fmaxf(p0[0], p0[1]), p1[0]), mb = __builtin_fmaxf(__builtin_fmaxf(p0[2], p0[3]), p1[1]);
            ma = __builtin_fmaxf(__builtin_fmaxf(ma, p1[2]), p1[3]);
#pragma unroll
            for (int r = 4; r < 16; r += 4) { ma = __builtin_fmaxf(__builtin_fmaxf(ma, p0[r]), p0[r + 1]); mb = __builtin_fmaxf(__builtin_fmaxf(mb, p0[r + 2]), p0[r + 3]);
                ma = __builtin_fmaxf(__builtin_fmaxf(ma, p1[r]), p1[r + 1]); mb = __builtin_fmaxf(__builtin_fmaxf(mb, p1[r + 2]), p1[r + 3]); }
            const float mx = half_max(__builtin_fmaxf(ma, mb));
            if (j == 0 || __any(mx > 8.0f)) {
                const float dl = j == 0 ? mx : __builtin_fmaxf(mx, 0.f);
                mrun[qb] += dl;
                const float alpha = __builtin_amdgcn_exp2f(-dl);
                lrun[qb] *= alpha;
#pragma unroll
                for (int r = 0; r < 16; ++r) { p0[r] -= dl; p1[r] -= dl; o[qb][0][r] *= alpha; o[qb][1][r] *= alpha; negm[qb][r] = -mrun[qb]; }
            }
            f32x2 ls2 = {0.f, 0.f};
#pragma unroll
            for (int r = 0; r < 16; r += 2) { p0[r] = __builtin_amdgcn_exp2f(p0[r]); p0[r + 1] = __builtin_amdgcn_exp2f(p0[r + 1]); p1[r] = __builtin_amdgcn_exp2f(p1[r]); p1[r + 1] = __builtin_amdgcn_exp2f(p1[r + 1]);
                ls2 += (f32x2){p0[r], p0[r + 1]}; ls2 += (f32x2){p1[r], p1[r + 1]}; }
            lrun[qb] += ls2.x + ls2.y;
        }
        const LAS unsigned char* vb = lds + buf * KV_BUF + 9216 + r32 * 136 + hi * 8;
#pragma unroll
        for (int j4 = 0; j4 < 4; ++j4) {
            bf16x8 pb[2];
#pragma unroll
            for (int qb = 0; qb < 2; ++qb) { const f32x16& ps = p[qb][j4 >> 1]; const int bs = 8 * (j4 & 1);
                u32x4 pw; pw.x = pk2(ps[bs], ps[bs + 1]); pw.y = pk2(ps[bs + 2], ps[bs + 3]); pw.z = pk2(ps[bs + 4], ps[bs + 5]); pw.w = pk2(ps[bs + 6], ps[bs + 7]);
                pb[qb] = __builtin_bit_cast(bf16x8, pw); }
            const u32x2 l0 = *(const LAS u32x2*)(vb + j4 * 32), h0 = *(const LAS u32x2*)(vb + j4 * 32 + 16);
            const u32x2 l1 = *(const LAS u32x2*)(vb + 32 * 136 + j4 * 32), h1 = *(const LAS u32x2*)(vb + 32 * 136 + j4 * 32 + 16);
            const bf16x8 va0 = __builtin_bit_cast(bf16x8, (u32x4){l0.x, l0.y, h0.x, h0.y});
            const bf16x8 va1 = __builtin_bit_cast(bf16x8, (u32x4){l1.x, l1.y, h1.x, h1.y});
#pragma unroll
            for (int qb = 0; qb < 2; ++qb) {
                o[qb][0] = __builtin_amdgcn_mfma_f32_32x32x16_bf16(va0, pb[qb], o[qb][0], 0, 0, 0);
                o[qb][1] = __builtin_amdgcn_mfma_f32_32x32x16_bf16(va1, pb[qb], o[qb][1], 0, 0, 0);
            }
        }
        if (j + 1 < ntiles) store_tile(buf ^ 1);
        __syncthreads();
    }
#pragma unroll
    for (int qb = 0; qb < 2; ++qb) {
        const float inv = __builtin_amdgcn_rcpf(half_sum(lrun[qb]));
        GAS bf16_t* op = MO + qrow[qb] * D + MO_ATT + hd[qb] * 64 + 4 * hi;
#pragma unroll
        for (int g = 0; g < 4; ++g) {
            u32x2 w0; w0.x = pk2(o[qb][0][4 * g] * inv, o[qb][0][4 * g + 1] * inv); w0.y = pk2(o[qb][0][4 * g + 2] * inv, o[qb][0][4 * g + 3] * inv);
            u32x2 w1; w1.x = pk2(o[qb][1][4 * g] * inv, o[qb][1][4 * g + 1] * inv); w1.y = pk2(o[qb][1][4 * g + 2] * inv, o[qb][1][4 * g + 3] * inv);
            *(GAS u32x2*)(op + 8 * g) = w0; *(GAS u32x2*)(op + 32 + 8 * g) = w1;
        }
    }
}

__device__ __forceinline__ void phase_scan(GAS unsigned char* ws, int G) {
    const int tid = tid_opq();
    const GAS unsigned* __restrict__ SBi = (const GAS unsigned*)(ws + WS_H); GAS unsigned* __restrict__ SBo = (GAS unsigned*)(ws + WS_H + SB_OUT_OFF);
    const GAS float* __restrict__ AV = (const GAS float*)(ws + WS_AV);
    for (int e = blockIdx.x * NTHR + tid; e < 64 * 2048; e += G * NTHR) {
        const int seq = e >> 11, pr = e & 2047, k = (2 * pr) & 63, dir = seq & 1;
        const GAS unsigned* __restrict__ sbi = SBi + (size_t)seq * NCH * 2048 + pr; GAS unsigned* __restrict__ sbo = SBo + (size_t)seq * NCH * 2048 + pr;
        const GAS float* __restrict__ av = AV + (size_t)seq * NCH * 64 + k;
        float S0 = 0.f, S1 = 0.f;
#pragma unroll 12
        for (int j = 0; j < NCH; ++j) {
            const int cj = dir == 0 ? j : (j < 4 ? 3 - j : 35 - (j - 4));
            const unsigned kv = sbi[(size_t)cj * 2048]; const f32x2 a2 = *(const GAS f32x2*)(av + cj * 64);
            sbo[(size_t)cj * 2048] = pk2(S0, S1);
            S0 = a2.x * S0 + __uint_as_float(kv << 16); S1 = a2.y * S1 + __uint_as_float(kv & 0xffff0000u);
        }
    }
}

#define XB_TMO      128
#define XB_XCNT(j)  (256  + 64 * (j))
#define XB_XSUB(j)  (1280 + 64 * (j))
#define XB_XGEN(j)  (2304 + 64 * (j))
#define XB_TOP      3328
#define XB_TOPGEN   3392
#define XCD_BAR_WORDS 3456
#define XB_SPIN_CAP (1u << 22)
__device__ __forceinline__ unsigned xb_ld(unsigned* p)              { return __hip_atomic_load(p, __ATOMIC_RELAXED, __HIP_MEMORY_SCOPE_AGENT); }
__device__ __forceinline__ unsigned xb_add(unsigned* p, unsigned v) { return __hip_atomic_fetch_add(p, v, __ATOMIC_RELAXED, __HIP_MEMORY_SCOPE_AGENT); }
__device__ __forceinline__ unsigned xb_xcc_id() { return (unsigned)__builtin_amdgcn_s_getreg((3 << 11) | 20) & 0xFu; }
#define XB_SPIN(cond, bar) do { unsigned _sp = 0; while (cond) { __builtin_amdgcn_s_sleep(1); \
    if ((++_sp & 255u) == 0u) { if (xb_ld(&(bar)[XB_TMO])) break; if (_sp > XB_SPIN_CAP) { atomicAdd(&(bar)[XB_TMO], 1u); break; } } } } while (0)
struct XcdBarrier { unsigned* bar; unsigned x; volatile LAS unsigned* st; };
__device__ __forceinline__ XcdBarrier xcd_barrier_post(unsigned* bar, volatile LAS unsigned* st, int tid) {
    XcdBarrier b; b.bar = bar; b.x = xb_xcc_id(); b.st = st;
    if (tid == 0) (void)xb_add(&bar[XB_XCNT(b.x)], 1u);
    return b;
}
__device__ __forceinline__ void xcd_barrier_complete(unsigned* bar, unsigned x, unsigned& nloc, unsigned& nx) {
    const unsigned G = gridDim.x * gridDim.y * gridDim.z;
    unsigned sum, cnt, mine, sp = 0u;
    for (;;) {
        sum = 0u; cnt = 0u; mine = 0u;
#pragma unroll
        for (unsigned j = 0; j < 16; ++j) { const unsigned c = xb_ld(&bar[XB_XCNT(j)]); sum += c; cnt += (c > 0u) ? 1u : 0u; mine = (j == x) ? c : mine; }
        if (sum == G) break;
        __builtin_amdgcn_s_sleep(1);
        if ((++sp & 255u) == 0u) { if (xb_ld(&bar[XB_TMO])) break; if (sp > XB_SPIN_CAP) { atomicAdd(&bar[XB_TMO], 1u); break; } }
    }
    nloc = mine > 0u ? mine : 1u; nx = cnt > 0u ? cnt : 1u;
}
__device__ __forceinline__ void xcd_barrier(const XcdBarrier& b, int tid) {
    asm volatile("s_waitcnt vmcnt(0)" ::: "memory");
    __syncthreads();
    if (tid == 0) {
        unsigned* bar = b.bar;
        __builtin_amdgcn_s_waitcnt(0);
        unsigned nloc = b.st[0], nx = b.st[1];
        if (nloc == 0u) { xcd_barrier_complete(bar, b.x, nloc, nx); b.st[0] = nloc; b.st[1] = nx; }
        const unsigned old = xb_add(&bar[XB_XSUB(b.x)], 1u);
        const unsigned gen = old / nloc;
        if (old + 1u == (gen + 1u) * nloc) {
            __builtin_amdgcn_fence(__ATOMIC_RELEASE, "agent");
            asm volatile("s_waitcnt vmcnt(0)" ::: "memory");
            const unsigned og = xb_add(&bar[XB_TOP], 1u);
            const unsigned tg = og / nx;
            if (og + 1u == (tg + 1u) * nx) xb_add(&bar[XB_TOPGEN], 1u);
            else XB_SPIN(xb_ld(&bar[XB_TOPGEN]) == tg, bar);
            __builtin_amdgcn_fence(__ATOMIC_ACQUIRE, "agent");
            xb_add(&bar[XB_XGEN(b.x)], 1u);
            asm volatile("s_waitcnt vmcnt(0)" ::: "memory");
        } else {
            XB_SPIN(xb_ld(&bar[XB_XGEN(b.x)]) == gen, bar);
            __builtin_amdgcn_fence(__ATOMIC_ACQUIRE, "agent");
            asm volatile("s_waitcnt vmcnt(0)" ::: "memory");
        }
    }
    __syncthreads();
}

__global__ void __launch_bounds__(NTHR, 2) mk_fwd(Args a) {
    extern __shared__ __attribute__((aligned(16))) unsigned char lds_raw[];
    LAS unsigned char* lds = (LAS unsigned char*)lds_raw;
    __shared__ int s_task;
    __shared__ unsigned xb_st[2];
    const int G = gridDim.x;
    if (threadIdx.x == 0) { xb_st[0] = 0u; xb_st[1] = 0u; }
    __syncthreads();
    const XcdBarrier xbar = xcd_barrier_post((unsigned*)(a.ws + WS_BAR), (volatile LAS unsigned*)xb_st, (int)threadIdx.x);
#define GRID_SYNC() xcd_barrier(xbar, tid_opq())

    for (int p = a.ph_lo; p < a.ph_hi; ++p) {
        if (ONLYP(100) && p == 0) phase_prologue(a, lds, G);
        else if (ONLYP(101) && p == 1) phase_modfinal(a, G);
        else {
            const int l = (p - 2) / 10, s = (p - 2) % 10;
            if (s == 7 || (s == 0 && l > 0)) continue;
            const bool last = (l == DEPTH - 1);
            const int Mpost = last ? ML : MA;
            for (int rep = 0; rep < REP_S[s]; ++rep) {
            if (rep > 0) GRID_SYNC();
            GAS unsigned char* ws = ((GAS unsigned char*)a.ws); asm volatile("" : "+s"(ws));
            GAS float* XL = ((GAS float*)a.out); asm volatile("" : "+s"(XL));
            ASSUME_GLOBAL(ws); ASSUME_GLOBAL(XL);
            GAS float* XC = (GAS float*)(ws + WS_XC);
            const GAS float* modf_l = (const GAS float*)(ws + WS_MODF) + (size_t)l * 9 * 6 * D;
            const GAS unsigned char* wl = ws + WS_W + l * W_LAYER;
            GAS float* dXL = rep ? (GAS float*)(ws + WS_PP) : XL; GAS float* dXC = rep ? (GAS float*)(ws + WS_PP) + (size_t)ML * D : XC;
            if (ONLYP(0) && s == 0) {
                phase_norm(l == 0 ? GIN(I_X) : XL, l == 0 ? GIN(I_CTX) : XC, (GAS bf16_t*)(ws + WS_H), modf_l, 1, 0, MA, G);
            } else if (ONLYP(1) && s == 1) {
                pg8::Gemm g{(const GAS bf16_t*)(ws + WS_H), (const GAS bf16_t*)(wl + WO_IN), MA, NIN, D, D, D}; pg8::StaticOrder S; S.init(MA, NIN, G, blockIdx.x, D / 64);
                pg8::EpiInProj E{(GAS bf16_t*)(ws + WS_PP), (GAS bf16_t*)(ws + WS_G)};
                pg8::gemm_phase<pg8::EpiInProj, true, pg8::StaticOrder>(lds, g, S, E);
            } else if (ONLYP(2) && s == 2) {
                const int wid = tid_opq() >> 6; const int gw = wid * G + blockIdx.x, NGW = G * 8;
                for (int t = gw; t < 8 * 4 * NCH * 2; t += NGW) hgrn_passA(t, l, ws, lds);
                if (NGW == 2048) {
                    if (gw < 256) prep_run(gw * 5, 5, l, ws, rep > 0);
                    else if (gw < 832) { vt_task(gw - 256, ws); prep_run(1280 + (gw - 256) * 8, 8, l, ws, rep > 0); }
                    else { const int w = gw - 832; if (w < 384) prep_run(5888 + w * 11, 11, l, ws, rep > 0); else prep_run(5888 + 384 * 11 + (w - 384) * 10, 10, l, ws, rep > 0); }
                } else {
                    for (int t = gw; t < 8 * 2 * 36; t += NGW) vt_task(t, ws);
                    for (int r = gw; r < MA / 9; r += NGW) prep_run(r * 9, 9, l, ws, rep > 0);
                }
            } else if (ONLYP(3) && s == 3) {
                phase_scan(ws, G);
            } else if (ONLYP(4) && s == 4) {
                const int NT = last ? 256 + 256 : 256 + 256 + 32;
                GAS int* ctr = (GAS int*)(ws + WS_CTL);
                const GAS bf16_t* Pp = (const GAS bf16_t*)(ws + WS_PP); const GAS bf16_t* Vt = (const GAS bf16_t*)(ws + WS_VT); GAS bf16_t* MO = (GAS bf16_t*)(ws + WS_MO);
                for (;;) {
                    const int tid = tid_opq(), wid = tid >> 6;
                    if (tid == 0) s_task = atomicAdd((int*)&ctr[64 * l + rep], 1);
                    __syncthreads();
                    const int t = s_task;
                    __syncthreads();
                    if (t >= NT) break;
                    if (t < 256) { const int first = (t * 9) >> 1, cnt = (((t + 1) * 9) >> 1) - first; if (wid < cnt) hgrn_passC(first + wid, l, ws, lds); }
                    else if (t < 512) { const int u = t - 256; const int hh = u & 3, qb = (u >> 2) & 3, bk = u >> 4; const int b = bk >> 1, kvh = bk & 1, head = kvh * 4 + hh;
                        attn_unit(lds, Pp, Vt, MO, b, kvh, b * SEQ + qb * 512, 64, 32, head, head, 0, SKV / 64); }
                    else { const int u = t - 512; const int b = u >> 2, hp = u & 3;
                        attn_unit(lds, Pp, Vt, MO, b, hp >> 1, ML + b * LCTX, 32, 0, 2 * hp, 2 * hp + 1, SEQ, LCTX / 64); }
                    __syncthreads();
                }
            } else if (ONLYP(5) && s == 5) {
                pg8::MergeOrder S; S.init(Mpost, G, blockIdx.x);
                pg8::Gemm g{(const GAS bf16_t*)(ws + WS_MO), (const GAS bf16_t*)(wl + WO_MG), Mpost, D, D, D, D};
                pg8::EpiMerge E{(const GAS bf16_t*)(ws + WS_G), (GAS bf16_t*)(ws + WS_H)};
                pg8::gemm_phase<pg8::EpiMerge, true, pg8::MergeOrder>(lds, g, S, E);
                if (!last && rep == 0 && (int)blockIdx.x >= 64) convert_layer(a, lds, l + 1, ((int)blockIdx.x - 64) * 8 + (tid_opq() >> 6), (G - 64) * 8, 0, 3);
            } else if (ONLYP(6) && s == 6) {
                pg8::Gemm g{(const GAS bf16_t*)(ws + WS_H), (const GAS bf16_t*)(wl + WO_O), Mpost, D, D, D, D}; pg8::StaticOrder S; S.init(Mpost, D, G, blockIdx.x, D / 64, true);
                pg8::EpiResidNorm E{l == 0 ? GIN(I_X) : XL, l == 0 ? GIN(I_CTX) : XC, XL, XC, modf_l + 2 * D, modf_l + 4 * D, modf_l + 3 * D, (GAS bf16_t*)(ws + WS_MO),
                    (GAS unsigned*)(ws + WS_NCNT) + (size_t)(l * 2 + 0) * 144 * 16, (GAS unsigned*)(ws + WS_XBUF), lds + pg8::STAGE_BYTES};
                pg8::gemm_phase<pg8::EpiResidNorm, true, pg8::StaticOrder>(lds, g, S, E);
                if (!last && rep == 0 && (int)blockIdx.x >= 64) convert_layer(a, lds, l + 1, ((int)blockIdx.x - 64) * 8 + (tid_opq() >> 6), (G - 64) * 8, 1, 3);
            } else if (ONLYP(7) && s == 7) {
                phase_norm(XL, XC, (GAS bf16_t*)(ws + WS_H), modf_l, 4, 3, Mpost, G);
            } else if (ONLYP(8) && s == 8) {
                pg8::Gemm g{(const GAS bf16_t*)(ws + WS_MO), (const GAS bf16_t*)(wl + WO_1), Mpost, NFF, D, D, D}; pg8::StaticOrder S; S.init(Mpost, NFF, G, blockIdx.x, D / 64);
                pg8::EpiSwiglu E{(GAS bf16_t*)(ws + WS_G)};
                pg8::gemm_phase<pg8::EpiSwiglu, true, pg8::StaticOrder>(lds, g, S, E);
            } else if (ONLYP(9)) {
                pg8::Gemm g{(const GAS bf16_t*)(ws + WS_G), (const GAS bf16_t*)(wl + WO_2), Mpost, D, DFF, DFF, DFF}; pg8::StaticOrder S; S.init(Mpost, D, G, blockIdx.x, DFF / 64, true);
                if (last) { pg8::EpiResid E{XL, XC, dXL, dXC, modf_l + 5 * D}; pg8::gemm_phase<pg8::EpiResid, true, pg8::StaticOrder>(lds, g, S, E); }
                else { const GAS float* modf_n = modf_l + (size_t)9 * 6 * D;
                    pg8::EpiResidNorm E{XL, XC, XL, XC, modf_l + 5 * D, modf_n + 1 * D, modf_n + 0 * D, (GAS bf16_t*)(ws + WS_H),
                        (GAS unsigned*)(ws + WS_NCNT) + (size_t)(l * 2 + 1) * 144 * 16, (GAS unsigned*)(ws + WS_XBUF), lds + pg8::STAGE_BYTES};
                    pg8::gemm_phase<pg8::EpiResidNorm, true, pg8::StaticOrder>(lds, g, S, E); }
                if (!last && rep == 0 && (int)blockIdx.x >= 64) convert_layer(a, lds, l + 1, ((int)blockIdx.x - 64) * 8 + (tid_opq() >> 6), (G - 64) * 8, 2, 3);
            }
            }
        }
        if (p + 1 < a.ph_hi) { if (a.ph_lo < 0) cg::this_grid().sync(); else GRID_SYNC(); }
    }
}

constexpr int N_PHASES = 2 + 10 * DEPTH;
extern "C" void kernel_launch(void* const* d_in, const int* in_sizes, int n_in, void* d_out, int out_size, void* d_ws, size_t ws_size, hipStream_t stream) {
    static int grid = 0;
    if (grid == 0) {
        if (n_in != 21 || out_size != ML * D || ws_size < WS_END) { fprintf(stderr, "kernel_launch: unexpected shapes (n_in %d out %d ws %zu need %zu)\n", n_in, out_size, ws_size, (size_t)WS_END); grid = -1; return; }
        int dev = 0, cus = 0, per_cu = 0;
        hipGetDevice(&dev); hipDeviceGetAttribute(&cus, hipDeviceAttributeMultiprocessorCount, dev);
        if (hipFuncSetAttribute((const void*)mk_fwd, hipFuncAttributeMaxDynamicSharedMemorySize, LDS_BYTES) != hipSuccess) { fprintf(stderr, "kernel_launch: hipFuncSetAttribute failed\n"); grid = -1; return; }
        if (hipOccupancyMaxActiveBlocksPerMultiprocessor(&per_cu, (const void*)mk_fwd, NTHR, LDS_BYTES) != hipSuccess || per_cu < 1) { fprintf(stderr, "kernel_launch: occupancy query says %d\n", per_cu); per_cu = 1; }
        (void)hipGetLastError();
        grid = cus * 1;
        fprintf(stderr, "kernel_launch: cus %d per_cu %d grid %d\n", cus, per_cu, grid);
    }
    if (grid < 0) return;
    hipMemsetAsync((char*)d_ws + WS_CTL, 0, 196608, stream);
    Args a{};
    for (int i = 0; i < 21; ++i) a.in[i] = (const float*)d_in[i];
    a.out = (float*)d_out; a.ws = (unsigned char*)d_ws;
#if MK_MULTI
    for (int p = 0; p < N_PHASES; ++p) { a.ph_lo = p; a.ph_hi = p + 1; hipLaunchKernelGGL(mk_fwd, dim3(grid), dim3(NTHR), LDS_BYTES, stream, a); }
#else
    a.ph_lo = 0; a.ph_hi = N_PHASES;
    void* args[] = {&a};
    hipError_t e = hipLaunchCooperativeKernel((const void*)mk_fwd, dim3(grid), dim3(NTHR), args, LDS_BYTES, stream);
    if (e != hipSuccess) fprintf(stderr, "kernel_launch: cooperative launch failed: %s (grid %d)\n", hipGetErrorString(e), grid);
#endif
}
```
